# Optimizing an MI355X kernel written in HIP

```python
import math
import jax, jax.numpy as jnp
from jax import lax
import numpy as np


D_MODEL = 1024
BATCH = 8
SEQ = 8192
DEPTH = 4

HEAD_DIM = 64
N_DIFF_HEADS = 4
DIFF_QK_WIDTH = N_DIFF_HEADS * 2 * HEAD_DIM
DIFF_V_WIDTH = N_DIFF_HEADS * 2 * HEAD_DIM
N_DIL_HEADS = 8
DIL_WIDTH = N_DIL_HEADS * HEAD_DIM
MIX_WIDTH = DIFF_V_WIDTH + DIL_WIDTH
PROJ_WIDTH = 2 * DIFF_QK_WIDTH + DIFF_V_WIDTH + 3 * DIL_WIDTH
DIL_PATTERNS = ((128, 1), (512, 4), (2048, 16))
Q_BLOCK = 128
D_FF = 2816
ROPE_THETA = 10000.0
EPS = 1e-6
SUBLN_EPS = 1e-5
LAMBDA_STD = 0.1
NEG_INF = -1e30

kernel_name = 'hybrid_diffattn_dilated_macaron'


def rmsnorm(x, g, eps=EPS):
    xf = x.astype(jnp.float32)
    y = xf * lax.rsqrt(jnp.mean(xf * xf, axis=-1, keepdims=True) + eps)
    return (y * g.astype(jnp.float32)).astype(x.dtype)


def swiglu(x, w_gate, w_up, w_down):
    return (jax.nn.silu(x @ w_gate) * (x @ w_up)) @ w_down


def rope_tables(positions):
    inv = 1.0 / (ROPE_THETA ** (jnp.arange(0, HEAD_DIM, 2, dtype=jnp.float32) / HEAD_DIM))
    ang = positions.astype(jnp.float32)[:, None] * inv[None, :]
    return jnp.cos(ang), jnp.sin(ang)


def apply_rope(t, cos, sin):
    t1, t2 = jnp.split(t.astype(jnp.float32), 2, axis=-1)
    c = cos[None, :, None, :]
    s = sin[None, :, None, :]
    return jnp.concatenate([t1 * c - t2 * s, t1 * s + t2 * c], axis=-1).astype(t.dtype)


def diff_attention(q, k, v, lam):
    B, S, H, _, E = q.shape
    nb = S // Q_BLOCK
    scale = E ** -0.5
    vf = v.astype(jnp.float32)
    kpos = jnp.arange(S)
    qb = q.reshape(B, nb, Q_BLOCK, H, 2, E).transpose(1, 0, 2, 3, 4, 5)

    def one_block(args):
        qblk, b = args
        s = jnp.einsum('bqhcd,bkhcd->bhcqk', qblk, k, preferred_element_type=jnp.float32) * scale
        qpos = b * Q_BLOCK + jnp.arange(Q_BLOCK)
        causal = kpos[None, :] <= qpos[:, None]
        s = jnp.where(causal[None, None, None], s, NEG_INF)
        p = jax.nn.softmax(s, axis=-1)
        a = p[:, :, 0] - lam * p[:, :, 1]
        return jnp.einsum('bhqk,bkhe->bqhe', a, vf)

    out = lax.map(one_block, (qb, jnp.arange(nb)))
    return out.transpose(1, 0, 2, 3, 4).reshape(B, S, H, 2 * E)


def dilated_branch(q, k, v, window, dilation):
    B, S, H, E = q.shape
    n = window // dilation
    L = S // dilation
    Lp = -(-L // n) * n
    nb = Lp // n

    def to_blocks(t):
        t = t.reshape(B, L, dilation, H, E).transpose(0, 2, 1, 3, 4)
        t = jnp.pad(t, ((0, 0), (0, 0), (0, Lp - L), (0, 0), (0, 0)))
        return t.reshape(B, dilation, nb, n, H, E)

    def band(t):
        prev = jnp.pad(t, ((0, 0), (0, 0), (1, 0), (0, 0), (0, 0), (0, 0)))[:, :, :-1]
        return jnp.concatenate([prev, t], axis=3)

    qb = to_blocks(q)
    kband = band(to_blocks(k))
    vband = band(to_blocks(v)).astype(jnp.float32)
    s = jnp.einsum('brnqhe,brnkhe->brnqhk', qb, kband, preferred_element_type=jnp.float32) * (E ** -0.5)
    qi = jnp.arange(n)[:, None] + n
    ki = jnp.arange(2 * n)[None, :]
    dist = qi - ki
    in_band = (dist >= 0) & (dist <= n)
    has_prev = (jnp.arange(nb) > 0)[:, None, None] | (ki >= n)[None]
    mask = in_band[None] & has_prev
    s = jnp.where(mask[None, None, :, :, None, :], s, NEG_INF)
    m = jnp.max(s, axis=-1)
    p = jnp.exp(s - m[..., None])
    den = jnp.sum(p, axis=-1)
    o = jnp.einsum('brnqhk,brnkhe->brnqhe', p, vband) / den[..., None]

    def from_blocks(t):
        t = t.reshape(B, dilation, Lp, H, -1)[:, :, :L]
        return t.transpose(0, 2, 1, 3, 4).reshape(B, S, H, -1)

    return from_blocks(o), from_blocks(m[..., None])[..., 0], from_blocks(den[..., None])[..., 0]


def dilated_mixture(q, k, v):
    outs = [dilated_branch(q, k, v, w, d) for (w, d) in DIL_PATTERNS]
    m_all = jnp.max(jnp.stack([m for (_, m, _) in outs], axis=0), axis=0)
    wts = [den * jnp.exp(m - m_all) for (_, m, den) in outs]
    num = sum(w[..., None] * o for w, (o, _, _) in zip(wts, outs))
    return num / sum(wts)[..., None]


def mixer(h, cos, sin, w_in, w_out, lq1, lk1, lq2, lk2, subln_gain, dil_gain, lam_init):
    B, S, _ = h.shape
    proj = h @ w_in
    o1 = DIFF_QK_WIDTH
    o2 = o1 + DIFF_QK_WIDTH
    o3 = o2 + DIFF_V_WIDTH
    o4 = o3 + DIL_WIDTH
    o5 = o4 + DIL_WIDTH
    dq, dk, dv, aq, ak, av = jnp.split(proj, [o1, o2, o3, o4, o5], axis=-1)

    dq = apply_rope(dq.reshape(B, S, 2 * N_DIFF_HEADS, HEAD_DIM), cos, sin).reshape(B, S, N_DIFF_HEADS, 2, HEAD_DIM)
    dk = apply_rope(dk.reshape(B, S, 2 * N_DIFF_HEADS, HEAD_DIM), cos, sin).reshape(B, S, N_DIFF_HEADS, 2, HEAD_DIM)
    dv = dv.reshape(B, S, N_DIFF_HEADS, 2 * HEAD_DIM)
    lam = (jnp.exp(jnp.sum(lq1.astype(jnp.float32) * lk1.astype(jnp.float32)))
           - jnp.exp(jnp.sum(lq2.astype(jnp.float32) * lk2.astype(jnp.float32))) + lam_init)
    d_out = diff_attention(dq, dk, dv, lam)
    d_out = rmsnorm(d_out, subln_gain, SUBLN_EPS) * (1.0 - lam_init)
    d_out = d_out.reshape(B, S, DIFF_V_WIDTH)

    aq = apply_rope(aq.reshape(B, S, N_DIL_HEADS, HEAD_DIM), cos, sin)
    ak = apply_rope(ak.reshape(B, S, N_DIL_HEADS, HEAD_DIM), cos, sin)
    av = av.reshape(B, S, N_DIL_HEADS, HEAD_DIM)
    a_out = dilated_mixture(aq, ak, av).reshape(B, S, DIL_WIDTH)
    a_out = rmsnorm(a_out, dil_gain)

    merged = jnp.concatenate([d_out, a_out], axis=-1).astype(h.dtype)
    return merged @ w_out


def setup_inputs(seed: int = 0) -> dict:
    key = jax.random.key(seed)
    ks = jax.random.split(key, 24)
    f32 = jnp.float32

    def nrm(k, shape, scale):
        return jax.random.normal(k, shape, f32) * scale

    def gain(k, shape):
        return 1.0 + 0.02 * jax.random.normal(k, shape, f32)

    return {
        'x': jax.random.normal(ks[0], (BATCH, SEQ, D_MODEL), f32),
        'positions': jnp.arange(SEQ, dtype=jnp.int32),
        'ffn1_norm': gain(ks[1], (DEPTH, D_MODEL)),
        'ffn1_gate': nrm(ks[2], (DEPTH, D_MODEL, D_FF), D_MODEL ** -0.5),
        'ffn1_up': nrm(ks[3], (DEPTH, D_MODEL, D_FF), D_MODEL ** -0.5),
        'ffn1_down': nrm(ks[4], (DEPTH, D_FF, D_MODEL), D_FF ** -0.5),
        'mix_norm': gain(ks[5], (DEPTH, D_MODEL)),
        'w_in': nrm(ks[6], (DEPTH, D_MODEL, PROJ_WIDTH), D_MODEL ** -0.5),
        'lambda_q1': nrm(ks[7], (DEPTH, HEAD_DIM), LAMBDA_STD),
        'lambda_k1': nrm(ks[8], (DEPTH, HEAD_DIM), LAMBDA_STD),
        'lambda_q2': nrm(ks[9], (DEPTH, HEAD_DIM), LAMBDA_STD),
        'lambda_k2': nrm(ks[10], (DEPTH, HEAD_DIM), LAMBDA_STD),
        'subln_gain': gain(ks[11], (DEPTH, 2 * HEAD_DIM)),
        'dil_gain': gain(ks[12], (DEPTH, DIL_WIDTH)),
        'w_out': nrm(ks[13], (DEPTH, MIX_WIDTH, D_MODEL), MIX_WIDTH ** -0.5),
        'ffn2_norm': gain(ks[14], (DEPTH, D_MODEL)),
        'ffn2_gate': nrm(ks[15], (DEPTH, D_MODEL, D_FF), D_MODEL ** -0.5),
        'ffn2_up': nrm(ks[16], (DEPTH, D_MODEL, D_FF), D_MODEL ** -0.5),
        'ffn2_down': nrm(ks[17], (DEPTH, D_FF, D_MODEL), D_FF ** -0.5),
        'final_norm': gain(ks[18], (D_MODEL,)),
    }


def reference(x, positions, ffn1_norm, ffn1_gate, ffn1_up, ffn1_down, mix_norm, w_in,
              lambda_q1, lambda_k1, lambda_q2, lambda_k2, subln_gain, dil_gain, w_out,
              ffn2_norm, ffn2_gate, ffn2_up, ffn2_down, final_norm):
    cos, sin = rope_tables(positions)
    for l in range(DEPTH):
        lam_init = 0.8 - 0.6 * math.exp(-0.3 * l)
        x = x + 0.5 * swiglu(rmsnorm(x, ffn1_norm[l]), ffn1_gate[l], ffn1_up[l], ffn1_down[l])
        x = x + mixer(rmsnorm(x, mix_norm[l]), cos, sin, w_in[l], w_out[l],
                      lambda_q1[l], lambda_k1[l], lambda_q2[l], lambda_k2[l],
                      subln_gain[l], dil_gain[l], lam_init)
        x = x + 0.5 * swiglu(rmsnorm(x, ffn2_norm[l]), ffn2_gate[l], ffn2_up[l], ffn2_down[l])
    return rmsnorm(x, final_norm)
```

```cpp
#include <hip/hip_runtime.h>
#include <hip/hip_cooperative_groups.h>
#include <cstdio>
#include <cstdint>
namespace cg = cooperative_groups;
#ifndef MK_PER_PHASE
#define MK_PER_PHASE 0
#endif
#ifndef REP_DIFF
#define REP_DIFF 1
#endif
#ifndef REP_DIL
#define REP_DIL 1
#endif
#ifndef REP_GU
#define REP_GU 1
#endif
#ifndef REP_PROJ
#define REP_PROJ 1
#endif
#ifndef REP_RES
#define REP_RES 1
#endif
#ifndef REP_MISC
#define REP_MISC 1
#endif
#ifndef REP_SYNC
#define REP_SYNC 1
#endif
namespace pg8 {
#define PG8_LAS __attribute__((address_space(3)))
typedef unsigned short bf16_t;
typedef short bf16x8 __attribute__((ext_vector_type(8)));
typedef float f32x4 __attribute__((ext_vector_type(4)));
typedef unsigned u32x4 __attribute__((ext_vector_type(4)));
constexpr int BM = 256, BK = 64, HALF = 128, HTB = HALF * BK * 2  , STAGE_BYTES = 8 * HTB, NXCD = 8, WGM = 4;

__host__ __device__ __forceinline__ int lds_byte(int r, int c) { const int st = (r >> 4) * 2 + (c >> 5), rr = r & 15, cc = c & 31, ob = rr * 64 + cc * 2; return st * 1024 + (ob ^ (((ob >> 9) & 1) << 5)); }
__host__ __device__ __forceinline__ void stage_rc(int b, int& R, int& C) { const int st = b / 1024, sb = b % 1024, swz = sb ^ (((sb >> 9) & 1) << 5); R = (st >> 1) * 16 + swz / 64; C = (st & 1) * 32 + (swz % 64) / 2; }
__host__ __device__ __forceinline__ int perm32(int rho) { const int n = rho >> 4, i = rho & 15; return 8 * (i >> 2) + 4 * n + (i & 3); }

struct Unit { int pm, pn; };
struct Gemm { const bf16_t* A; const bf16_t* Bt; int M, N, K; };

struct StaticOrder {
    int nM, nN, nwg, G, c;
    __host__ __device__ void init(int M, int N, int G_, int c_) { nM = M / BM; nN = N / BM; nwg = nM * nN; G = G_; c = c_; }
    __host__ __device__ bool next(int i, Unit& u) const {
        const long L = (long)i * G + c; if (L >= nwg) return false;
        int wgid = (int)L; { const int q = nwg / NXCD, r = nwg % NXCD, xcd = wgid % NXCD, off = wgid / NXCD; wgid = (xcd < r ? xcd * (q + 1) : r * (q + 1) + (xcd - r) * q) + off; }
        const int nig = WGM * nN, gid = wgid / nig, fm = gid * WGM, gsz = (nM - fm) < WGM ? (nM - fm) : WGM;
        u.pm = fm + ((wgid % nig) % gsz); u.pn = (wgid % nig) / gsz; return true;
    }
    __device__ __forceinline__ void a_ready(const Unit&) const {}
    __device__ __forceinline__ void done(const Unit&) const {}
};
__device__ __forceinline__ unsigned cvt_pk_bf16(float lo, float hi) { unsigned r; asm volatile("v_cvt_pk_bf16_f32 %0, %1, %2" : "=v"(r) : "v"(lo), "v"(hi)); return r; }
typedef float f32x2 __attribute__((ext_vector_type(2)));
typedef unsigned u32x2 __attribute__((ext_vector_type(2)));
constexpr int NSSP = 16;
__device__ __forceinline__ void rows_rstd(float (&rs)[8], const float* ssp, int row0, int fq, float mul) {
    f32x4 v[8];
#pragma unroll
    for (int j = 0; j < 8; ++j) v[j] = ((const f32x4*)(ssp + (size_t)(row0 + (j >> 2) * HALF + (j & 3) * 16) * NSSP))[fq];
#pragma unroll
    for (int j = 0; j < 8; ++j) {
        float t = (v[j][0] + v[j][1]) + (v[j][2] + v[j][3]);
        t += __shfl_xor(t, 16); t += __shfl_xor(t, 32);
        rs[j] = mul * __builtin_amdgcn_rsqf(t * (1.0f / 1024.0f) + 1e-6f);
    }
}
struct EpiGU {
    static constexpr bool PERM = true, AFTER_DRAIN = false;
    bf16_t* H; const float* ssp; int ldh;
    __device__ __forceinline__ void operator()(const f32x4 (&acc)[2][2][4][2], const Unit& u, int wr, int wc, int fr_, int fq_) const {
        int fr = fr_, fq = fq_; asm volatile("" : "+v"(fr), "+v"(fq));
        const int row0 = u.pm * BM + wr * 64 + fr, col0 = u.pn * HALF + wc * 32 + 8 * fq;
        float rsv[8]; rows_rstd(rsv, ssp, row0, fq, 1.0f);
#pragma unroll
        for (int ai = 0; ai < 2; ++ai)
#pragma unroll
            for (int m = 0; m < 4; ++m) {
                const int row = row0 + ai * HALF + m * 16;
                const float rs = rsv[ai * 4 + m], rsn = -1.4426950408889634f * rs, rs2 = rs * rs;
                f32x2 t[4], ab[4];
#pragma unroll
                for (int q = 0; q < 4; ++q) {
                    const f32x2 a2 = (f32x2){acc[ai][0][m][q >> 1][(2 * q) & 3], acc[ai][0][m][q >> 1][(2 * q + 1) & 3]};
                    const f32x2 b2 = (f32x2){acc[ai][1][m][q >> 1][(2 * q) & 3], acc[ai][1][m][q >> 1][(2 * q + 1) & 3]};
                    t[q] = a2 * rsn; ab[q] = (a2 * b2) * rs2;
                }
#pragma unroll
                for (int q = 0; q < 4; ++q) { t[q].x = __builtin_amdgcn_exp2f(t[q].x); t[q].y = __builtin_amdgcn_exp2f(t[q].y); }
#pragma unroll
                for (int q = 0; q < 4; ++q) t[q] = t[q] + 1.0f;
#pragma unroll
                for (int q = 0; q < 4; ++q) { t[q].x = __builtin_amdgcn_rcpf(t[q].x); t[q].y = __builtin_amdgcn_rcpf(t[q].y); }
#pragma unroll
                for (int q = 0; q < 4; ++q) ab[q] = ab[q] * t[q];
                u32x4 w; w.x = cvt_pk_bf16(ab[0].x, ab[0].y); w.y = cvt_pk_bf16(ab[1].x, ab[1].y); w.z = cvt_pk_bf16(ab[2].x, ab[2].y); w.w = cvt_pk_bf16(ab[3].x, ab[3].y);
                *(u32x4*)(H + (size_t)row * ldh + col0) = w;
            }
    }
};
struct EpiRes {
    static constexpr bool PERM = true, AFTER_DRAIN = false;
    bf16_t* XB; float* ssp; float scale;
    __device__ __forceinline__ void operator()(const f32x4 (&acc)[2][2][4][2], const Unit& u, int wr, int wc, int fr_, int fq_) const {
        int fr = fr_, fq = fq_; asm volatile("" : "+v"(fr), "+v"(fq));
        const int row0 = u.pm * BM + wr * 64 + fr, col0 = u.pn * BM + wc * 32 + 8 * fq;
#pragma unroll
        for (int ai = 0; ai < 2; ++ai) {
            u32x4 xv[4][2];
#pragma unroll
            for (int m = 0; m < 4; ++m)
#pragma unroll
                for (int bj = 0; bj < 2; ++bj) xv[m][bj] = *(const u32x4*)(XB + (size_t)(row0 + ai * HALF + m * 16) * 1024 + col0 + bj * HALF);
#pragma unroll
            for (int m = 0; m < 4; ++m) {
                const int row = row0 + ai * HALF + m * 16;
                float ss = 0.f;
#pragma unroll
                for (int bj = 0; bj < 2; ++bj) {
                    float o[8];
#pragma unroll
                    for (int q = 0; q < 4; ++q) {
                        const unsigned wd = xv[m][bj][q];
                        const float x0 = __builtin_bit_cast(float, wd << 16), x1 = __builtin_bit_cast(float, wd & 0xffff0000u);
                        o[2 * q] = x0 + acc[ai][bj][m][q >> 1][(2 * q) & 3] * scale;
                        o[2 * q + 1] = x1 + acc[ai][bj][m][q >> 1][(2 * q + 1) & 3] * scale;
                    }
#pragma unroll
                    for (int q = 0; q < 8; ++q) ss += o[q] * o[q];
                    u32x4 w; w.x = cvt_pk_bf16(o[0], o[1]); w.y = cvt_pk_bf16(o[2], o[3]); w.z = cvt_pk_bf16(o[4], o[5]); w.w = cvt_pk_bf16(o[6], o[7]);
                    *(u32x4*)(XB + (size_t)row * 1024 + col0 + bj * HALF) = w;
                }
                ss += __shfl_xor(ss, 16); ss += __shfl_xor(ss, 32);
                if (fq == 0) ssp[(size_t)row * NSSP + u.pn * 4 + wc] = ss;
            }
            asm volatile("" ::: "memory");
        }
    }
};
struct EpiProj {
    static constexpr bool PERM = true, AFTER_DRAIN = false;
    bf16_t* P; const float* ssp; const float* cs;
    __device__ __forceinline__ void operator()(const f32x4 (&acc)[2][2][4][2], const Unit& u, int wr, int wc, int fr_, int fq_) const {
        int fr = fr_, fq = fq_; asm volatile("" : "+v"(fr), "+v"(fq));
        const int row0 = u.pm * BM + wr * 64 + fr;
        const int t = u.pn;
        const bool rope = !(t == 4 || t == 5 || t == 10 || t == 11);
        const float qs = (t < 2 || t == 6 || t == 7) ? 0.125f * 1.4426950408889634f : 1.0f;
        const int colL = t * BM + wc * 64 + 8 * fq;
        float rsv[8]; rows_rstd(rsv, ssp, row0, fq, qs);
#pragma unroll
        for (int hb = 0; hb < 4; ++hb) {
            const int ai = hb >> 1;
            f32x4 cv[2][4];
            if (rope) {
#pragma unroll
                for (int mm = 0; mm < 2; ++mm) {
                    const int m = (hb & 1) * 2 + mm;
                    const float* cp = cs + (size_t)((row0 + ai * HALF + m * 16) & 8191) * 64 + 8 * fq;
                    cv[mm][0] = *(const f32x4*)(cp); cv[mm][1] = *(const f32x4*)(cp + 4); cv[mm][2] = *(const f32x4*)(cp + 32); cv[mm][3] = *(const f32x4*)(cp + 36);
                }
            }
#pragma unroll
            for (int mm = 0; mm < 2; ++mm) {
                const int m = (hb & 1) * 2 + mm;
                const int row = row0 + ai * HALF + m * 16;
                const float rs = rsv[ai * 4 + m];
                float o1[8], o2[8];
                if (rope) {
                    const f32x4 c0 = cv[mm][0], c1 = cv[mm][1], s0 = cv[mm][2], s1 = cv[mm][3];
#pragma unroll
                    for (int i = 0; i < 4; ++i) {
                        const float a0 = acc[ai][0][m][0][i] * rs, b0 = acc[ai][1][m][0][i] * rs, a1 = acc[ai][0][m][1][i] * rs, b1 = acc[ai][1][m][1][i] * rs;
                        o1[i] = a0 * c0[i] - b0 * s0[i]; o2[i] = a0 * s0[i] + b0 * c0[i];
                        o1[4 + i] = a1 * c1[i] - b1 * s1[i]; o2[4 + i] = a1 * s1[i] + b1 * c1[i];
                    }
                } else {
#pragma unroll
                    for (int i = 0; i < 4; ++i) { o1[i] = acc[ai][0][m][0][i] * rs; o1[4 + i] = acc[ai][0][m][1][i] * rs; o2[i] = acc[ai][1][m][0][i] * rs; o2[4 + i] = acc[ai][1][m][1][i] * rs; }
                }
                u32x4 w1, w2;
                w1.x = cvt_pk_bf16(o1[0], o1[1]); w1.y = cvt_pk_bf16(o1[2], o1[3]); w1.z = cvt_pk_bf16(o1[4], o1[5]); w1.w = cvt_pk_bf16(o1[6], o1[7]);
                w2.x = cvt_pk_bf16(o2[0], o2[1]); w2.y = cvt_pk_bf16(o2[2], o2[3]); w2.z = cvt_pk_bf16(o2[4], o2[5]); w2.w = cvt_pk_bf16(o2[6], o2[7]);
                bf16_t* pr = P + (size_t)row * 3072 + colL;
                *(u32x4*)(pr) = w1; *(u32x4*)(pr + 32) = w2;
            }
            asm volatile("" ::: "memory");
        }
    }
};
template <class Epi, class Sched, bool ALIGN_EPI = false, bool SP2 = false>
__device__ __forceinline__ void gemm_phase(PG8_LAS unsigned char* lds, const Gemm g, const Sched& S, const Epi& E) {
    int tid_ = threadIdx.x; asm volatile("" : "+v"(tid_));
    const int tid = tid_, wid = __builtin_amdgcn_readfirstlane(tid >> 6), lane = tid & 63, wr = wid >> 2, wc = wid & 3, fr = lane & 15, fq = lane >> 4;
    const int K = g.K, nt = K / BK;
    unsigned voffA[2], voffB[2];
#pragma unroll
    for (int i = 0; i < 2; ++i) { int R, C; stage_rc(tid * 16 + i * 8192, R, C); const int Rb = Epi::PERM ? ((R & ~31) + perm32(R & 31)) : R;
        voffA[i] = (unsigned)(R * K + C) * 2u; voffB[i] = (unsigned)(Rb * K + C) * 2u; }
    const size_t kstep = (size_t)(BK * 2);
    const size_t hstep = (size_t)HALF * K * 2;
    const size_t tstep = 2 * hstep;
    const unsigned ldsw = (unsigned)wid * 1024u;
    const int aoff = lds_byte(wr * 64 + fr, fq * 8), boff = lds_byte(wc * 32 + fr, fq * 8);
#define PG8_SA(b, h) (((b) * 2 + (h)) * HTB)
#define PG8_SB(b, h) ((4 + (b) * 2 + (h)) * HTB)
#define PG8_STAGE(bufoff, gbase, voff) do { _Pragma("unroll") for (int _i = 0; _i < 2; ++_i) \
        __builtin_amdgcn_global_load_lds((const unsigned*)((const char*)(gbase) + (voff)[_i]), (PG8_LAS unsigned*)(lds + (bufoff) + ldsw + _i * 8192), 16, 0, 0); } while (0)
#define PG8_LDA(dst, b, h) do { _Pragma("unroll") for (int m = 0; m < 4; ++m) _Pragma("unroll") for (int k = 0; k < 2; ++k) dst[m][k] = *(const PG8_LAS bf16x8*)(lds + PG8_SA(b, h) + aoff + m * 2048 + k * 1024); } while (0)
#define PG8_LDB(dst, b, h) do { _Pragma("unroll") for (int n = 0; n < 2; ++n) _Pragma("unroll") for (int k = 0; k < 2; ++k) dst[n][k] = *(const PG8_LAS bf16x8*)(lds + PG8_SB(b, h) + boff + n * 2048 + k * 1024); } while (0)
#define PG8_MMA(ai, bj, At, Bt) do { __builtin_amdgcn_s_setprio(1); _Pragma("unroll") for (int m = 0; m < 4; ++m) _Pragma("unroll") for (int n = 0; n < 2; ++n) _Pragma("unroll") for (int k = 0; k < 2; ++k) \
        acc[ai][bj][m][n] = __builtin_amdgcn_mfma_f32_16x16x32_bf16(Bt[n][k], At[m][k], acc[ai][bj][m][n], 0, 0, 0); __builtin_amdgcn_s_setprio(0); } while (0)
#define PG8_WAIT_V(n) asm volatile("s_waitcnt vmcnt(" #n ")" ::: "memory")
#define PG8_WAIT_L(n) asm volatile("s_waitcnt lgkmcnt(" #n ")" ::: "memory")
#define PG8_BAR __builtin_amdgcn_s_barrier()
#define PG8_SCHED __builtin_amdgcn_sched_barrier(0)
    Unit cur, nxt; int ui = 0;
    if (!S.next(0, cur)) return;
    f32x4 acc[2][2][4][2];
#pragma unroll
    for (int a = 0; a < 2; ++a)
#pragma unroll
        for (int b = 0; b < 2; ++b)
#pragma unroll
            for (int m = 0; m < 4; ++m)
#pragma unroll
                for (int n = 0; n < 2; ++n) acc[a][b][m][n] = (f32x4){0.f, 0.f, 0.f, 0.f};
    bf16x8 At[4][2], B0[2][2], B1[2][2];
    const char* cA = (const char*)g.A + (size_t)cur.pm * tstep; const char* cB = (const char*)g.Bt + (size_t)cur.pn * tstep;
    S.a_ready(cur);
    if constexpr (SP2) {
        PG8_STAGE(PG8_SB(0, 0), cB, voffB); PG8_STAGE(PG8_SB(0, 1), cB + hstep, voffB); PG8_STAGE(PG8_SA(0, 0), cA, voffA); PG8_STAGE(PG8_SA(0, 1), cA + hstep, voffA);
        if (wr == 1) PG8_BAR;
        PG8_WAIT_V(2); PG8_BAR;
        PG8_STAGE(PG8_SB(1, 0), cB + kstep, voffB); PG8_STAGE(PG8_SA(1, 0), cA + kstep, voffA); PG8_STAGE(PG8_SB(1, 1), cB + hstep + kstep, voffB);
        PG8_WAIT_V(6); PG8_BAR;
    } else {
        PG8_STAGE(PG8_SB(0, 0), cB, voffB); PG8_STAGE(PG8_SA(0, 0), cA, voffA); PG8_STAGE(PG8_SB(0, 1), cB + hstep, voffB); PG8_STAGE(PG8_SA(0, 1), cA + hstep, voffA);
        if (wr == 1) PG8_BAR;
        PG8_WAIT_V(4); PG8_BAR;
        PG8_STAGE(PG8_SB(1, 0), cB + kstep, voffB); PG8_STAGE(PG8_SA(1, 0), cA + kstep, voffA); PG8_STAGE(PG8_SB(1, 1), cB + hstep + kstep, voffB);
        PG8_WAIT_V(6); PG8_BAR;
    }
    for (;;) {
        const bool has_next = S.next(ui + 1, nxt);
        const char* nA = has_next ? (const char*)g.A + (size_t)nxt.pm * tstep : cA; const char* nB = has_next ? (const char*)g.Bt + (size_t)nxt.pn * tstep : cB;
        for (int t = 0; t < nt; t += 2) {
            const bool last = (t == nt - 2);
            const char* a1 = cA + (size_t)(t + 1) * kstep;
            const char* a2 = last ? nA : cA + (size_t)(t + 2) * kstep; const char* b2 = last ? nB : cB + (size_t)(t + 2) * kstep;
            const char* a3 = a2 + kstep; const char* b3 = b2 + kstep;
            if (last && has_next) S.a_ready(nxt);
            if constexpr (SP2) {
            PG8_LDB(B0, 0, 0); PG8_LDB(B1, 0, 1); PG8_SCHED; PG8_LDA(At, 0, 0); PG8_STAGE(PG8_SA(1, 1), a1 + hstep, voffA);
            PG8_WAIT_V(8); PG8_WAIT_L(0); PG8_BAR; PG8_MMA(0, 0, At, B0); PG8_MMA(0, 1, At, B1); PG8_BAR; PG8_SCHED;
            PG8_LDA(At, 0, 1); PG8_STAGE(PG8_SB(0, 0), b2, voffB); PG8_STAGE(PG8_SB(0, 1), b2 + hstep, voffB); PG8_STAGE(PG8_SA(0, 0), a2, voffA);
            PG8_WAIT_V(8); PG8_WAIT_L(0); PG8_BAR; PG8_MMA(1, 0, At, B0); PG8_MMA(1, 1, At, B1); PG8_BAR; PG8_SCHED;
            PG8_LDB(B0, 1, 0); PG8_LDB(B1, 1, 1); PG8_SCHED; PG8_LDA(At, 1, 0); PG8_STAGE(PG8_SA(0, 1), a2 + hstep, voffA);
            PG8_WAIT_V(8); PG8_WAIT_L(0); PG8_BAR; PG8_MMA(0, 0, At, B0); PG8_MMA(0, 1, At, B1); PG8_BAR; PG8_SCHED;
            PG8_LDA(At, 1, 1); PG8_STAGE(PG8_SB(1, 0), b3, voffB); PG8_STAGE(PG8_SB(1, 1), b3 + hstep, voffB); PG8_STAGE(PG8_SA(1, 0), a3, voffA);
            PG8_WAIT_V(8); PG8_WAIT_L(0); PG8_BAR; PG8_MMA(1, 0, At, B0); PG8_MMA(1, 1, At, B1); PG8_BAR; PG8_SCHED;
            } else {
            PG8_LDB(B0, 0, 0); PG8_SCHED; PG8_LDA(At, 0, 0); PG8_STAGE(PG8_SA(1, 1), a1 + hstep, voffA);
            PG8_WAIT_L(8); PG8_BAR; PG8_WAIT_L(0); PG8_MMA(0, 0, At, B0); PG8_BAR; PG8_SCHED;
            PG8_LDB(B1, 0, 1); PG8_STAGE(PG8_SB(0, 0), b2, voffB);
            PG8_BAR; PG8_WAIT_L(0); PG8_MMA(0, 1, At, B1); PG8_BAR;
            PG8_LDA(At, 0, 1); PG8_STAGE(PG8_SA(0, 0), a2, voffA);
            PG8_BAR; PG8_WAIT_L(0); PG8_MMA(1, 0, At, B0); PG8_BAR; PG8_SCHED;
            PG8_STAGE(PG8_SB(0, 1), b2 + hstep, voffB);
            PG8_WAIT_V(6); PG8_BAR; PG8_MMA(1, 1, At, B1); PG8_BAR;
            PG8_LDB(B0, 1, 0); PG8_SCHED; PG8_LDA(At, 1, 0); PG8_STAGE(PG8_SA(0, 1), a2 + hstep, voffA);
            PG8_WAIT_L(8); PG8_BAR; PG8_WAIT_L(0); PG8_MMA(0, 0, At, B0); PG8_BAR; PG8_SCHED;
            PG8_LDB(B1, 1, 1); PG8_STAGE(PG8_SB(1, 0), b3, voffB);
            PG8_BAR; PG8_WAIT_L(0); PG8_MMA(0, 1, At, B1); PG8_BAR;
            PG8_LDA(At, 1, 1); PG8_STAGE(PG8_SA(1, 0), a3, voffA);
            PG8_BAR; PG8_WAIT_L(0); PG8_MMA(1, 0, At, B0); PG8_BAR; PG8_SCHED;
            PG8_STAGE(PG8_SB(1, 1), b3 + hstep, voffB);
            PG8_WAIT_V(6); PG8_BAR; PG8_MMA(1, 1, At, B1); PG8_BAR;
            }
        }
        if constexpr (ALIGN_EPI) { if (wr == 0) PG8_BAR; }
        if constexpr (!Epi::AFTER_DRAIN) { E(acc, cur, wr, wc, fr, fq); S.done(cur); }
        if (!has_next) break;
#pragma unroll
        for (int a = 0; a < 2; ++a)
#pragma unroll
            for (int b = 0; b < 2; ++b)
#pragma unroll
                for (int m = 0; m < 4; ++m)
#pragma unroll
                    for (int n = 0; n < 2; ++n) acc[a][b][m][n] = (f32x4){0.f, 0.f, 0.f, 0.f};
        cur = nxt; cA = nA; cB = nB; ++ui;
        if constexpr (ALIGN_EPI) { if (wr == 1) PG8_BAR; }
    }
    PG8_WAIT_V(0);
    if constexpr (!ALIGN_EPI) { if (wr == 0) PG8_BAR; }
    PG8_BAR;
    if constexpr (Epi::AFTER_DRAIN) { E.fused(acc, cur, wr, wc, fr, fq, lds, wid, lane); S.done(cur); }
#undef PG8_SA
#undef PG8_SB
#undef PG8_STAGE
#undef PG8_LDA
#undef PG8_LDB
#undef PG8_MMA
#undef PG8_WAIT_V
#undef PG8_WAIT_L
#undef PG8_BAR
#undef PG8_SCHED
}
}

constexpr int NB = 8, S = 8192, D = 1024, FF = 2816, PW = 3072, M = NB * S, DEPTH = 4;
constexpr int NWAVES = 8, NTHR = 512;
#define LAS __attribute__((address_space(3)))
typedef unsigned short bf16;
typedef float f32x4 __attribute__((ext_vector_type(4)));
typedef float f32x2 __attribute__((ext_vector_type(2)));
typedef unsigned u32x4 __attribute__((ext_vector_type(4)));
typedef unsigned u32x2 __attribute__((ext_vector_type(2)));

__device__ __forceinline__ int ltid() { int t = threadIdx.x; asm volatile("" : "+v"(t)); return t; }
namespace at {
typedef short bf16x8 __attribute__((ext_vector_type(8)));
typedef short s16x4 __attribute__((ext_vector_type(4)));
typedef float f32x16 __attribute__((ext_vector_type(16)));
constexpr int KROW = 144, KBUF = 64 * KROW, VBUF = 16384, ATT_LDS = 2 * KBUF + 2 * VBUF;
constexpr float NEGF = -1e30f;
__device__ __forceinline__ unsigned cvtpk(float lo, float hi) { typedef __bf16 b2 __attribute__((ext_vector_type(2))); f32x2 v = {lo, hi}; b2 b = __builtin_convertvector(v, b2); return __builtin_bit_cast(unsigned, b); }
__device__ __forceinline__ float max3f(float a, float b, float c) { float r; asm("v_max3_f32 %0, %1, %2, %3" : "=v"(r) : "v"(a), "v"(b), "v"(c)); return r; }
__device__ __forceinline__ float partner_max(float v) { auto rr = __builtin_amdgcn_permlane32_swap(__float_as_uint(v), __float_as_uint(v), false, false); return fmaxf(__uint_as_float(rr[0]), __uint_as_float(rr[1])); }
__device__ __forceinline__ float partner_sum(float v) { auto rr = __builtin_amdgcn_permlane32_swap(__float_as_uint(v), __float_as_uint(v), false, false); return __uint_as_float(rr[0]) + __uint_as_float(rr[1]); }
__device__ __forceinline__ s16x4 vtr(const LAS unsigned char* p) { typedef short v4i16_t __attribute__((ext_vector_type(4))); return __builtin_bit_cast(s16x4, __builtin_amdgcn_ds_read_tr16_b64_v4i16((LAS v4i16_t*)p)); }
__device__ __forceinline__ bf16x8 pack8(const f32x16& p, int b) {
    u32x4 w; w.x = cvtpk(p[b], p[b + 1]); w.y = cvtpk(p[b + 2], p[b + 3]); w.z = cvtpk(p[b + 4], p[b + 5]); w.w = cvtpk(p[b + 6], p[b + 7]); return __builtin_bit_cast(bf16x8, w);
}

template <int DV>
__device__ __forceinline__ void sweep(LAS unsigned char* lds, const bf16* Kb, const bf16* Vb, size_t rstride, int t_lo, int t_hi, int W, int ql, int wq_lo,
                                      const bf16x8 (&qf)[4], f32x16 (&o)[DV / 32], float& m, float& l) {
    constexpr int NV = DV / 64, ND = DV / 32;
    const int tid = ltid(), lane = tid & 63, r32 = lane & 31, hi = lane >> 5;
    const int krow = tid >> 3, kch = tid & 7;
    const bf16* kg = Kb + (size_t)krow * rstride + kch * 8;
    const int kwoff = krow * KROW + kch * 16;
    const int vrow0 = (DV == 64) ? ((tid >> 4) * 2 + ((tid >> 2) & 1)) : ((tid >> 5) * 2 + ((tid >> 2) & 1));
    const int vch = (DV == 64) ? (((tid >> 3) & 1) * 4 + (tid & 3)) : (((tid >> 3) & 3) * 4 + (tid & 3));
    const bf16* vg = Vb + (size_t)vrow0 * rstride + vch * 8;
    int vwoff[NV];
#pragma unroll
    for (int i = 0; i < NV; ++i) { const int vr = vrow0 + 32 * i; vwoff[i] = (vch >> 2) * 4096 + (vr >> 4) * 1024 + (vr & 15) * 64 + (vch & 3) * 16; }
    const size_t tstep = (size_t)64 * rstride;
    u32x4 kregA, vregA[NV], kregB, vregB[NV];
#define AT_LOAD(KR_, VR_, T_) do { KR_ = *(const u32x4*)(kg + (size_t)(T_) * tstep); \
        _Pragma("unroll") for (int i = 0; i < NV; ++i) VR_[i] = *(const u32x4*)(vg + (size_t)(T_) * tstep + (size_t)(32 * i) * rstride); } while (0)
#define AT_WRITE(KR_, VR_) do { *(LAS u32x4*)(kbuf + kwoff) = KR_; \
        _Pragma("unroll") for (int i = 0; i < NV; ++i) *(LAS u32x4*)(vbuf + vwoff[i]) = VR_[i]; } while (0)
    AT_LOAD(kregA, vregA, t_lo);
    if (t_lo + 1 < t_hi) AT_LOAD(kregB, vregB, t_lo + 1);
    const int kroff = r32 * KROW + hi * 16;
    const int vroff = (4 * hi + ((lane & 15) >> 2)) * 64 + ((lane >> 4) & 1) * 32 + (lane & 3) * 8;
    const f32x16 negm = {};
#define AT_TILE() do { \
        const int k0 = t * 64; \
        const bool relevant = (k0 <= wq_lo + 31) && (wq_lo - (k0 + 63) <= W); \
        if (relevant) { \
            bf16x8 kf[8]; \
_Pragma("unroll") \
            for (int d0 = 0; d0 < 4; ++d0) { kf[2 * d0] = *(const LAS bf16x8*)(kbuf + kroff + d0 * 32); kf[2 * d0 + 1] = *(const LAS bf16x8*)(kbuf + kroff + 32 * KROW + d0 * 32); } \
            f32x16 p0, p1; \
            p0 = __builtin_amdgcn_mfma_f32_32x32x16_bf16(kf[0], qf[0], negm, 0, 0, 0); \
            p1 = __builtin_amdgcn_mfma_f32_32x32x16_bf16(kf[1], qf[0], negm, 0, 0, 0); \
_Pragma("unroll") \
            for (int d0 = 1; d0 < 4; ++d0) { \
                p0 = __builtin_amdgcn_mfma_f32_32x32x16_bf16(kf[2 * d0], qf[d0], p0, 0, 0, 0); \
                p1 = __builtin_amdgcn_mfma_f32_32x32x16_bf16(kf[2 * d0 + 1], qf[d0], p1, 0, 0, 0); \
            } \
 \
            s16x4 vlo[2][4], vhh[2][4]; \
_Pragma("unroll") \
            for (int ks = 0; ks < 4; ++ks) { vlo[0][ks] = vtr(vbuf + vroff + ks * 1024); vhh[0][ks] = vtr(vbuf + vroff + ks * 1024 + 512); } \
            __builtin_amdgcn_sched_barrier(0); \
            const bool full = (k0 + 63 <= wq_lo) && (wq_lo + 31 - k0 <= W); \
            if (!full) { \
_Pragma("unroll") \
                for (int r = 0; r < 16; ++r) { \
                    const int kv = k0 + (r & 3) + 8 * (r >> 2) + 4 * hi; \
                    const bool v0 = (kv <= ql) && (ql - kv <= W), v1 = (kv + 32 <= ql) && (ql - kv - 32 <= W); \
                    p0[r] = v0 ? p0[r] : NEGF; p1[r] = v1 ? p1[r] : NEGF; \
                } \
            } \
            asm volatile("s_nop 15\n\ts_nop 7" : "+v"(p0), "+v"(p1)); \
            float rm; \
            { float a = max3f(p0[0], p0[1], p1[0]), b = max3f(p0[2], p0[3], p1[1]); a = max3f(a, p1[2], p1[3]); \
_Pragma("unroll") \
              for (int r = 4; r < 16; r += 4) { a = max3f(a, p0[r], p0[r + 1]); b = max3f(b, p0[r + 2], p0[r + 3]); a = max3f(a, p1[r], p1[r + 1]); b = max3f(b, p1[r + 2], p1[r + 3]); } \
              rm = fmaxf(a, b); } \
            rm = partner_max(rm); \
            if (__builtin_expect(__any(rm > m + 8.0f), 0)) { \
                const float mn = fmaxf(m, rm); \
                const float f = __builtin_amdgcn_exp2f(m - mn); \
                m = mn; l *= f; \
_Pragma("unroll") \
                for (int d = 0; d < ND; ++d) o[d] = o[d] * f; \
            } \
            if (__builtin_expect(__any(m != 0.f), 0)) { \
_Pragma("unroll") \
                for (int r = 0; r < 16; ++r) { p0[r] -= m; p1[r] -= m; } \
            } \
            float s0 = 0.f, s1 = 0.f; \
_Pragma("unroll") \
            for (int r = 0; r < 16; ++r) { p0[r] = __builtin_amdgcn_exp2f(p0[r]); p1[r] = __builtin_amdgcn_exp2f(p1[r]); s0 += p0[r]; asm volatile("" : "+v"(s0)); s1 += p1[r]; asm volatile("" : "+v"(s1)); } \
            l += s0 + s1; \
            bf16x8 pa[4]; \
            pa[0] = pack8(p0, 0); pa[1] = pack8(p0, 8); pa[2] = pack8(p1, 0); pa[3] = pack8(p1, 8); \
_Pragma("unroll") \
            for (int d = 0; d < ND; ++d) { \
                if (d + 1 < ND) { \
_Pragma("unroll") \
                    for (int ks = 0; ks < 4; ++ks) { vlo[(d + 1) & 1][ks] = vtr(vbuf + vroff + (d + 1) * 4096 + ks * 1024); vhh[(d + 1) & 1][ks] = vtr(vbuf + vroff + (d + 1) * 4096 + ks * 1024 + 512); } \
                } \
_Pragma("unroll") \
                for (int ks = 0; ks < 4; ++ks) { \
                    const s16x4 lo = vlo[d & 1][ks], hh = vhh[d & 1][ks]; \
                    const bf16x8 vf = (bf16x8){lo[0], lo[1], lo[2], lo[3], hh[0], hh[1], hh[2], hh[3]}; \
                    o[d] = __builtin_amdgcn_mfma_f32_32x32x16_bf16(vf, pa[ks], o[d], 0, 0, 0); \
                } \
                if (d + 1 < ND) __builtin_amdgcn_sched_barrier(0); \
            } \
        } \
    } while (0)

    for (int tt = t_lo, st = 0; tt < t_hi; tt += 2, ++st) {
        LAS unsigned char* kb0 = lds + (st & 1) * 2 * KBUF;
        LAS unsigned char* vb0 = lds + 4 * KBUF + (st & 1) * 2 * VBUF;
        { LAS unsigned char* kbuf = kb0; LAS unsigned char* vbuf = vb0; AT_WRITE(kregA, vregA); }
        { LAS unsigned char* kbuf = kb0 + KBUF; LAS unsigned char* vbuf = vb0 + VBUF; AT_WRITE(kregB, vregB); }
        __syncthreads();
        if (tt + 2 < t_hi) { AT_LOAD(kregA, vregA, tt + 2); AT_LOAD(kregB, vregB, tt + 3); }
        { LAS unsigned char* kbuf = kb0; LAS unsigned char* vbuf = vb0; const int t = tt; AT_TILE(); }
        { LAS unsigned char* kbuf = kb0 + KBUF; LAS unsigned char* vbuf = vb0 + VBUF; const int t = tt + 1; AT_TILE(); }
    }
#undef AT_LOAD
#undef AT_WRITE
    __syncthreads();
}

__device__ __forceinline__ void diff_unit(LAS unsigned char* lds, const bf16* proj, bf16* merged, float* stash, float lam, int b, int h, int qb, int blk) {
    const int tid = ltid(), lane = tid & 63, r32 = lane & 31, hi = lane >> 5;
    const int wid = __builtin_amdgcn_readfirstlane(tid >> 6);
    const size_t rowbase = (size_t)b * S;
    const int wq_lo = qb * 256 + wid * 32, ql = wq_lo + r32;
    const bf16* qrow = proj + (rowbase + ql) * PW + h * 128;
    const bf16* kb = proj + rowbase * PW + 512 + h * 128;
    const bf16* vb = proj + rowbase * PW + 1024 + h * 128;
    float* st = stash + ((size_t)blk * NTHR + tid) * 64;
    f32x16 o[4]; float inv = 0.f;
#pragma unroll 1
    for (int comp = 0; comp < 2; ++comp) {
        bf16x8 qf[4];
#pragma unroll
        for (int d0 = 0; d0 < 4; ++d0) qf[d0] = *(const bf16x8*)(qrow + comp * 64 + 16 * d0 + 8 * hi);
#pragma unroll
        for (int d = 0; d < 4; ++d) o[d] = (f32x16){};
        float m = 0.f, l = 0.f;
        sweep<128>(lds, kb + comp * 64, vb, (size_t)PW, 0, 4 * qb + 4, 1 << 30, ql, wq_lo, qf, o, m, l);
        l = partner_sum(l);
        inv = 1.0f / l;
        if (comp == 0) {
#pragma unroll
            for (int d = 0; d < 4; ++d)
#pragma unroll
                for (int r4 = 0; r4 < 4; ++r4)
                    *(f32x4*)(st + d * 16 + r4 * 4) = (f32x4){o[d][4 * r4] * inv, o[d][4 * r4 + 1] * inv, o[d][4 * r4 + 2] * inv, o[d][4 * r4 + 3] * inv};
        }
    }
    float ss = 0.f;
    const float li = lam * inv;
#pragma unroll
    for (int d = 0; d < 4; ++d)
#pragma unroll
        for (int r4 = 0; r4 < 4; ++r4) {
            const f32x4 s1 = *(const f32x4*)(st + d * 16 + r4 * 4);
#pragma unroll
            for (int i = 0; i < 4; ++i) { const float v = s1[i] - li * o[d][4 * r4 + i]; o[d][4 * r4 + i] = v; ss += v * v; }
        }
    ss = partner_sum(ss);
    const float rs = __builtin_amdgcn_rsqf(ss * (1.0f / 128.0f) + 1e-5f);
    bf16* orow = merged + (rowbase + ql) * D + h * 128 + 4 * hi;
#pragma unroll
    for (int d = 0; d < 4; ++d)
#pragma unroll
        for (int r4 = 0; r4 < 4; ++r4) {
            u32x2 w; w.x = cvtpk(o[d][4 * r4] * rs, o[d][4 * r4 + 1] * rs); w.y = cvtpk(o[d][4 * r4 + 2] * rs, o[d][4 * r4 + 3] * rs);
            *(u32x2*)(orow + 32 * d + 8 * r4) = w;
        }
}

__device__ __forceinline__ void dil_unit(LAS unsigned char* lds, const bf16* proj, bf16* part, f32x2* ml, int b, int head, int dil, int res, int lblk) {
    const int tid = ltid(), lane = tid & 63, r32 = lane & 31, hi = lane >> 5;
    const int wid = __builtin_amdgcn_readfirstlane(tid >> 6);
    const int wq_lo = lblk * 256 + wid * 32, ql = wq_lo + r32;
    const size_t row = (size_t)b * S + (size_t)ql * dil + res;
    const bf16* qrow = proj + row * PW + 1536 + head * 64;
    const bf16* kb = proj + ((size_t)b * S + res) * PW + 2048 + head * 64;
    const bf16* vb = proj + ((size_t)b * S + res) * PW + 2560 + head * 64;
    bf16x8 qf[4];
#pragma unroll
    for (int d0 = 0; d0 < 4; ++d0) qf[d0] = *(const bf16x8*)(qrow + 16 * d0 + 8 * hi);
    f32x16 o[2]; o[0] = (f32x16){}; o[1] = (f32x16){};
    float m = 0.f, l = 0.f;
    const int t_lo = (4 * lblk - 2) > 0 ? (4 * lblk - 2) : 0;
    sweep<64>(lds, kb, vb, (size_t)dil * PW, t_lo, 4 * lblk + 4, 128, ql, wq_lo, qf, o, m, l);
    l = partner_sum(l);
    const float inv = 1.0f / l;
    bf16* orow = part + row * 512 + head * 64 + 4 * hi;
#pragma unroll
    for (int d = 0; d < 2; ++d)
#pragma unroll
        for (int r4 = 0; r4 < 4; ++r4) {
            u32x2 w; w.x = cvtpk(o[d][4 * r4] * inv, o[d][4 * r4 + 1] * inv); w.y = cvtpk(o[d][4 * r4 + 2] * inv, o[d][4 * r4 + 3] * inv);
            *(u32x2*)(orow + 32 * d + 8 * r4) = w;
        }
    if (hi == 0) ml[row * 8 + head] = (f32x2){m, l};
}

__device__ __forceinline__ void dil_stream(LAS unsigned char* lds, const bf16* proj, bf16* part_base, f32x2* ml_base, int u0, int ustep, int utotal) {
    constexpr int ND = 2, W = 128, VB = 8192, VOFF = 6 * KBUF;
    const int tid = ltid(), lane = tid & 63, r32 = lane & 31, hi = lane >> 5;
    const int wid = __builtin_amdgcn_readfirstlane(tid >> 6);
    const int krow = tid >> 3, kch = tid & 7;
    const int kwoff = krow * KROW + kch * 16;
    const int vrow0 = (tid >> 4) * 2 + ((tid >> 2) & 1), vch = ((tid >> 3) & 1) * 4 + (tid & 3);
    const int vwoff = (vch >> 2) * 4096 + (vrow0 >> 4) * 1024 + (vrow0 & 15) * 64 + (vch & 3) * 16;
    const int kroff = r32 * KROW + hi * 16;
    const int vroff = (4 * hi + ((lane & 15) >> 2)) * 64 + ((lane >> 4) & 1) * 32 + (lane & 3) * 8;
    u32x4 kst[6], vst[6]; bf16x8 qn[4];
    int u = u0; if (u >= utotal) return;
    int cb, chead, cdil, cres, clblk, cbr;
#define DS_DECODE(U_) do { cbr = (U_) >> 11; const int rem_ = (U_) & 2047, bhd_ = rem_ >> 5, blk_ = rem_ & 31; const int sh_ = (cbr == 0) ? 5 : (cbr == 1 ? 3 : 1); \
        cdil = (cbr == 0) ? 1 : (cbr == 1 ? 4 : 16); cb = bhd_ >> 3; chead = bhd_ & 7; cres = blk_ >> sh_; clblk = blk_ & ((1 << sh_) - 1); } while (0)
#define DS_LOAD() do { const int tl_ = (4 * clblk - 2) > 0 ? (4 * clblk - 2) : 0, nt_ = 4 * clblk + 4 - tl_; \
        const bf16* base_ = proj + ((size_t)cb * S + cres) * PW + chead * 64; const size_t rs_ = (size_t)cdil * PW; \
        _Pragma("unroll") for (int j = 0; j < 6; ++j) if (j < nt_) { \
            kst[j] = *(const u32x4*)(base_ + 2048 + (size_t)((tl_ + j) * 64 + krow) * rs_ + kch * 8); \
            vst[j] = *(const u32x4*)(base_ + 2560 + (size_t)((tl_ + j) * 64 + vrow0) * rs_ + vch * 8); } \
        const bf16* q_ = proj + ((size_t)cb * S + (size_t)(clblk * 256 + wid * 32 + r32) * cdil + cres) * PW + 1536 + chead * 64 + 8 * hi; \
        _Pragma("unroll") for (int d0 = 0; d0 < 4; ++d0) qn[d0] = *(const bf16x8*)(q_ + 16 * d0); } while (0)
    DS_DECODE(u);
    DS_LOAD();
    for (;;) {
        const int t_lo = (4 * clblk - 2) > 0 ? (4 * clblk - 2) : 0, ntu = 4 * clblk + 4 - t_lo;
#pragma unroll
        for (int j = 0; j < 6; ++j) if (j < ntu) { *(LAS u32x4*)(lds + j * KBUF + kwoff) = kst[j]; *(LAS u32x4*)(lds + VOFF + j * VB + vwoff) = vst[j]; }
        bf16x8 qf[4];
#pragma unroll
        for (int d0 = 0; d0 < 4; ++d0) qf[d0] = qn[d0];
        __syncthreads();
        const int wq_lo = clblk * 256 + wid * 32, ql = wq_lo + r32;
        const size_t row = (size_t)cb * S + (size_t)ql * cdil + cres;
        const int head = chead;
        bf16* part = part_base + (size_t)cbr * M * 512; f32x2* ml = ml_base + (size_t)cbr * M * 8;
        const int un = u + ustep; const bool has_next = un < utotal;
        if (has_next) { DS_DECODE(un); DS_LOAD(); }
        f32x16 o[2]; o[0] = (f32x16){}; o[1] = (f32x16){};
        float m = 0.f, l = 0.f;
        const f32x16 negm = {};
#pragma unroll 1
        for (int j = 0; j < ntu; ++j) {
            LAS unsigned char* kbuf = lds + j * KBUF;
            LAS unsigned char* vbuf = lds + VOFF + j * VB;
            const int t = t_lo + j;
            AT_TILE();
        }
        l = partner_sum(l);
        const float inv = 1.0f / l;
        bf16* orow = part + row * 512 + head * 64 + 4 * hi;
#pragma unroll
        for (int d = 0; d < 2; ++d)
#pragma unroll
            for (int r4 = 0; r4 < 4; ++r4) {
                u32x2 w; w.x = cvtpk(o[d][4 * r4] * inv, o[d][4 * r4 + 1] * inv); w.y = cvtpk(o[d][4 * r4 + 2] * inv, o[d][4 * r4 + 3] * inv);
                *(u32x2*)(orow + 32 * d + 8 * r4) = w;
            }
        if (hi == 0) ml[row * 8 + head] = (f32x2){m, l};
        __syncthreads();
        if (!has_next) break;
        u = un;
    }
#undef DS_DECODE
#undef DS_LOAD
}
#undef AT_TILE
}

constexpr size_t MiB = (size_t)1 << 20;
constexpr size_t WS_ROPE = 1 * MiB;
constexpr size_t WS_SSP = 3 * MiB;
constexpr size_t WS_W = 8 * MiB;
constexpr size_t W_GU1 = 0, W_D1 = 11 * MiB, W_GU2 = W_D1 + 5 * MiB + 512 * 1024, W_D2 = W_GU2 + 11 * MiB, W_IN = W_D2 + 5 * MiB + 512 * 1024, W_OUT = W_IN + 6 * MiB;
constexpr size_t WS_XB = 64 * MiB;
constexpr size_t WS_PROJ = 192 * MiB;
constexpr size_t WS_MRG = 576 * MiB;
constexpr size_t WS_PART = 704 * MiB;
constexpr size_t WS_ML = 896 * MiB;
constexpr size_t WS_STASH = 908 * MiB;
constexpr size_t WS_W1 = 940 * MiB;
constexpr size_t WS_END = 984 * MiB;
constexpr int LDS_BYTES = 147456;

#define XB_TMO      128
#define XB_XCNT(j)  (256  + 64 * (j))
#define XB_XSUB(j)  (1280 + 64 * (j))
#define XB_XGEN(j)  (2304 + 64 * (j))
#define XB_TOP      3328
#define XB_TOPGEN   3392
#define XCD_BAR_WORDS 3456
#define XB_SPIN_CAP (1u << 18)

__device__ __forceinline__ unsigned xb_ld(unsigned* p)              { return __hip_atomic_load(p, __ATOMIC_RELAXED, __HIP_MEMORY_SCOPE_AGENT); }
__device__ __forceinline__ unsigned xb_add(unsigned* p, unsigned v) { return __hip_atomic_fetch_add(p, v, __ATOMIC_RELAXED, __HIP_MEMORY_SCOPE_AGENT); }
__device__ __forceinline__ unsigned xb_xcc_id() { return (unsigned)__builtin_amdgcn_s_getreg((3 << 11) | 20) & 0xFu; }
#define XB_SPIN(cond, bar) do { unsigned _sp = 0; while (cond) { __builtin_amdgcn_s_sleep(1); \
    if ((++_sp & 255u) == 0u) { if (xb_ld(&(bar)[XB_TMO])) break; if (_sp > XB_SPIN_CAP) { atomicAdd(&(bar)[XB_TMO], 1u); break; } } } } while (0)

struct XcdBarrier {
    unsigned* bar; unsigned x;
    volatile LAS unsigned* st;
};

__device__ __forceinline__ XcdBarrier xcd_barrier_post(unsigned* bar, volatile LAS unsigned* st) {
    XcdBarrier b; b.bar = bar; b.x = xb_xcc_id(); b.st = st;
    if (threadIdx.x == 0) (void)xb_add(&bar[XB_XCNT(b.x)], 1u);
    return b;
}
__device__ __forceinline__ void xcd_barrier_complete(unsigned* bar, unsigned x, unsigned& nloc, unsigned& nx) {
    const unsigned G = gridDim.x * gridDim.y * gridDim.z;
    unsigned sum, cnt, mine, sp = 0u;
    for (;;) {
        sum = 0u; cnt = 0u; mine = 0u;
#pragma unroll
        for (unsigned j = 0; j < 16; ++j) { const unsigned c = xb_ld(&bar[XB_XCNT(j)]); sum += c; cnt += (c > 0u) ? 1u : 0u; mine = (j == x) ? c : mine; }
        if (sum == G) break;
        __builtin_amdgcn_s_sleep(1);
        if ((++sp & 255u) == 0u) { if (xb_ld(&bar[XB_TMO])) break; if (sp > XB_SPIN_CAP) { atomicAdd(&bar[XB_TMO], 1u); break; } }
    }
    nloc = mine > 0u ? mine : 1u; nx = cnt > 0u ? cnt : 1u;
}

__device__ __forceinline__ void xcd_barrier(const XcdBarrier& b) {
    asm volatile("s_waitcnt vmcnt(0)" ::: "memory");
    __syncthreads();
    if (threadIdx.x == 0) {
        unsigned* bar = b.bar;
        __builtin_amdgcn_s_waitcnt(0);
        unsigned nloc = b.st[0], nx = b.st[1];
        if (nloc == 0u) { xcd_barrier_complete(bar, b.x, nloc, nx); b.st[0] = nloc; b.st[1] = nx; }
        const unsigned old = xb_add(&bar[XB_XSUB(b.x)], 1u);
        const unsigned gen = old / nloc;
        if (old + 1u == (gen + 1u) * nloc) {
            __builtin_amdgcn_fence(__ATOMIC_RELEASE, "agent");
            asm volatile("s_waitcnt vmcnt(0)" ::: "memory");
            const unsigned og = xb_add(&bar[XB_TOP], 1u);
            const unsigned tg = og / nx;
            if (og + 1u == (tg + 1u) * nx) xb_add(&bar[XB_TOPGEN], 1u);
            else XB_SPIN(xb_ld(&bar[XB_TOPGEN]) == tg, bar);
            __builtin_amdgcn_fence(__ATOMIC_ACQUIRE, "agent");
            xb_add(&bar[XB_XGEN(b.x)], 1u);
            asm volatile("s_waitcnt vmcnt(0)" ::: "memory");
        } else {
            XB_SPIN(xb_ld(&bar[XB_XGEN(b.x)]) == gen, bar);
            __builtin_amdgcn_fence(__ATOMIC_ACQUIRE, "agent");
            asm volatile("s_waitcnt vmcnt(0)" ::: "memory");
        }
    }
    __syncthreads();
}

constexpr size_t WS_BAR = 0, BAR_ZERO_BYTES = 16384;
constexpr int LDS_MISC = 131072 + 512;
struct Args { const void* in[20]; float* out; unsigned char* ws; float lam_init[4]; int ph_lo, ph_hi; };

__device__ __forceinline__ float wave_sum(float v) {
#pragma unroll
    for (int o = 1; o < 64; o <<= 1) v += __shfl_xor(v, o);
    return v;
}
__device__ __forceinline__ unsigned f2bf(float f) { unsigned u = __builtin_bit_cast(unsigned, f); return (u + 0x7fffu + ((u >> 16) & 1u)) >> 16; }
__device__ __forceinline__ unsigned pk2(float lo, float hi) { return f2bf(lo) | (f2bf(hi) << 16); }
__device__ __forceinline__ float bf2f(unsigned short h) { return __builtin_bit_cast(float, (unsigned)h << 16); }

__device__ __forceinline__ void conv_item(const float* W, int K, int N, bf16* WT, int rmode, int part, int gmode, const float* g0, const float* g1, float gs, LAS float* scr, int item, int lane) {
    const int nblk = N / 32, kb = item / nblk, nb = item % nblk, k0 = 64 * kb, n0 = 32 * nb;
#pragma unroll 8
    for (int i = 0; i < 32; ++i) {
        const int kk = 2 * i + (lane >> 5), k = k0 + kk;
        float g = 1.0f;
        if (gmode == 1) g = g0[k]; else if (gmode == 2) g = (k < 512) ? g0[k & 127] * gs : g1[k - 512];
        scr[kk * 33 + (lane & 31)] = W[(size_t)k * N + n0 + (lane & 31)] * g;
    }
    asm volatile("s_waitcnt lgkmcnt(0)" ::: "memory");
    const int c = lane & 7;
#pragma unroll
    for (int j = 0; j < 4; ++j) {
        const int nl = (lane >> 3) + 8 * j, n = n0 + nl; const LAS float* s = scr + (8 * c) * 33 + nl;
        int rowd = n;
        if (rmode == 1) rowd = ((n >> 7) << 8) + part * 128 + (n & 127);
        else if (rmode == 2) { const int cc = n & 255; rowd = (n & ~255) + ((cc >> 5) & 1) * 128 + (cc >> 6) * 32 + (cc & 31); }
        u32x4 o; o.x = pk2(s[0 * 33], s[1 * 33]); o.y = pk2(s[2 * 33], s[3 * 33]); o.z = pk2(s[4 * 33], s[5 * 33]); o.w = pk2(s[6 * 33], s[7 * 33]);
        *(u32x4*)(WT + (size_t)rowd * K + k0 + 8 * c) = o;
    }
    asm volatile("s_waitcnt lgkmcnt(0)" ::: "memory");
}

typedef const Args __attribute__((address_space(4)))* ArgsP;
__device__ __forceinline__ void convert_layer(ArgsP ap, int l, LAS unsigned char* lds, int gw, int ngw, int wave, int lane) {
    LAS float* scr = (LAS float*)(lds + wave * 16384);
    unsigned char* wb = ap->ws + ((l & 1) ? WS_W1 : WS_W);
    constexpr int I_G = (D / 64) * (FF / 32), I_D = (FF / 64) * (D / 32), I_IN = (D / 64) * (PW / 32), I_OUT = (D / 64) * (D / 32);
    constexpr int NITEMS = 4 * I_G + 2 * I_D + I_IN + I_OUT;
    const size_t wgu = (size_t)D * FF;
    const float* n1 = (const float*)ap->in[2] + l * D; const float* n2 = (const float*)ap->in[15] + l * D; const float* nm = (const float*)ap->in[6] + l * D;
    for (int it = gw; it < NITEMS; it += ngw) {
        int r = it;
        if (r < I_G) { conv_item((const float*)ap->in[3] + l * wgu, D, FF, (bf16*)(wb + W_GU1), 1, 0, 1, n1, nullptr, 1.f, scr, r, lane); continue; } r -= I_G;
        if (r < I_G) { conv_item((const float*)ap->in[4] + l * wgu, D, FF, (bf16*)(wb + W_GU1), 1, 1, 1, n1, nullptr, 1.f, scr, r, lane); continue; } r -= I_G;
        if (r < I_D) { conv_item((const float*)ap->in[5] + l * wgu, FF, D, (bf16*)(wb + W_D1), 0, 0, 0, nullptr, nullptr, 1.f, scr, r, lane); continue; } r -= I_D;
        if (r < I_G) { conv_item((const float*)ap->in[16] + l * wgu, D, FF, (bf16*)(wb + W_GU2), 1, 0, 1, n2, nullptr, 1.f, scr, r, lane); continue; } r -= I_G;
        if (r < I_G) { conv_item((const float*)ap->in[17] + l * wgu, D, FF, (bf16*)(wb + W_GU2), 1, 1, 1, n2, nullptr, 1.f, scr, r, lane); continue; } r -= I_G;
        if (r < I_D) { conv_item((const float*)ap->in[18] + l * wgu, FF, D, (bf16*)(wb + W_D2), 0, 0, 0, nullptr, nullptr, 1.f, scr, r, lane); continue; } r -= I_D;
        if (r < I_IN) { conv_item((const float*)ap->in[7] + (size_t)l * D * PW, D, PW, (bf16*)(wb + W_IN), 2, 0, 1, nm, nullptr, 1.f, scr, r, lane); continue; } r -= I_IN;
        conv_item((const float*)ap->in[14] + (size_t)l * D * D, D, D, (bf16*)(wb + W_OUT), 0, 0, 2, (const float*)ap->in[12] + l * 128, (const float*)ap->in[13] + l * 512, 1.0f - ap->lam_init[l], scr, r, lane);
    }
}

__global__ void __launch_bounds__(NTHR, 2) mega(Args a) {
    extern __shared__ __attribute__((aligned(16))) unsigned char lds_raw[];
    LAS unsigned char* lds = (LAS unsigned char*)lds_raw;
    const int ph_lo = a.ph_lo, ph_hi = a.ph_hi;
    volatile LAS unsigned* bst = (volatile LAS unsigned*)(lds + LDS_MISC);
    if (threadIdx.x < 2) bst[threadIdx.x] = 0u;
    __syncthreads();
    XcdBarrier bar; bar.bar = (unsigned*)(a.ws + WS_BAR); bar.x = 0; bar.st = bst;
    if (ph_hi - ph_lo > 1) bar = xcd_barrier_post((unsigned*)(a.ws + WS_BAR), bst);
    for (int ph = ph_lo; ph < ph_hi; ++ph) {
        const int tid = ltid(), lane = tid & 63, wave = __builtin_amdgcn_readfirstlane(tid >> 6);
        int G = gridDim.x, bx = blockIdx.x; asm volatile("" : "+s"(G), "+s"(bx));
        const int vcu = (G % 8 == 0) ? (bx % 8) * (G / 8) + bx / 8 : bx;
        const int gw = vcu * NWAVES + wave, ngw = G * NWAVES;
        ArgsP ap = (ArgsP)__builtin_amdgcn_kernarg_segment_ptr();
        asm volatile("" : "+s"(ap));
        unsigned char* ws = ap->ws;
        float* X = ap->out;
        bf16* XB = (bf16*)(ws + WS_XB);
        float* ssp = (float*)(ws + WS_SSP);
        float* cs = (float*)(ws + WS_ROPE);
        bf16* PROJ = (bf16*)(ws + WS_PROJ);
        bf16* HB = (bf16*)(ws + WS_PROJ);
        bf16* MRG = (bf16*)(ws + WS_MRG);
        if (ph == 0) {
            const float* xin = (const float*)ap->in[0];
            for (int row = gw; row < M; row += ngw) {
                const f32x4* xr = (const f32x4*)(xin + (size_t)row * D) + lane;
                u32x2* xb = (u32x2*)(XB + (size_t)row * D) + lane;
                float s = 0.f;
#pragma unroll
                for (int j = 0; j < 4; ++j) {
                    const f32x4 v = xr[64 * j]; s += (v[0] * v[0] + v[1] * v[1]) + (v[2] * v[2] + v[3] * v[3]);
                    u32x2 w; w.x = pk2(v[0], v[1]); w.y = pk2(v[2], v[3]); xb[64 * j] = w;
                }
                s = wave_sum(s);
                if (lane < 16) ssp[(size_t)row * 16 + lane] = (lane == 0) ? s : 0.f;
            }
            const int* pos = (const int*)ap->in[1];
            for (int idx = bx * NTHR + tid; idx < S * 32; idx += G * NTHR) {
                const int s_ = idx >> 5, j = idx & 31;
                double inv = 1.0; for (int q = 0; q < j; ++q) inv *= 0.7498942093324559;
                const float invf = (float)inv;
                const float angf = (float)pos[s_] * invf;
                const double ang = (double)angf;
                const double kk = __builtin_rint(ang * 0.15915494309189535);
                const double r = ang - kk * 6.283185307179586;
                const double x2 = r * r;
                double c = 1.0, sn = r, tc = 1.0, ts = r;
#pragma unroll
                for (int k = 1; k <= 14; ++k) { tc *= -x2 / (double)((2 * k - 1) * (2 * k)); c += tc; ts *= -x2 / (double)((2 * k) * (2 * k + 1)); sn += ts; }
                cs[(size_t)s_ * 64 + j] = (float)c; cs[(size_t)s_ * 64 + 32 + j] = (float)sn;
            }
            convert_layer(ap, 0, lds, gw, ngw, wave, lane);
        } else if (ph == 1 + 8 * DEPTH) {
            const float* g = (const float*)ap->in[19];
            for (int row = gw; row < M; row += ngw) {
                const u32x2* xb = (const u32x2*)(XB + (size_t)row * D) + lane;
                f32x4* xo = (f32x4*)(X + (size_t)row * D) + lane;
                f32x4 v[4]; float s = 0.f;
#pragma unroll
                for (int j = 0; j < 4; ++j) { const u32x2 w = xb[64 * j];
                    v[j] = (f32x4){__builtin_bit_cast(float, w.x << 16), __builtin_bit_cast(float, w.x & 0xffff0000u), __builtin_bit_cast(float, w.y << 16), __builtin_bit_cast(float, w.y & 0xffff0000u)};
                    s += (v[j][0] * v[j][0] + v[j][1] * v[j][1]) + (v[j][2] * v[j][2] + v[j][3] * v[j][3]); }
                const float rs = 1.0f / sqrtf(wave_sum(s) * (1.0f / D) + 1e-6f);
#pragma unroll
                for (int j = 0; j < 4; ++j) { const f32x4 gg = ((const f32x4*)g)[lane + 64 * j]; xo[64 * j] = v[j] * rs * gg; }
            }
        } else {
            const int l = (ph - 1) / 8, k = (ph - 1) % 8;
            unsigned char* wb = ws + ((l & 1) ? WS_W1 : WS_W);
            if (k == 0 || k == 6) {
                pg8::Gemm g{XB, (const bf16*)(wb + (k == 0 ? W_GU1 : W_GU2)), M, 2 * FF, D};
                pg8::StaticOrder SO; SO.init(M, 2 * FF, G, bx);
                pg8::EpiGU E{HB, ssp, FF};
#ifndef SK_GU
                for (int rep_ = 0; rep_ < REP_GU; ++rep_)
                pg8::gemm_phase<pg8::EpiGU, pg8::StaticOrder, true, true>(lds, g, SO, E);
#endif
            } else if (k == 1 || k == 7 || k == 5) {
                pg8::Gemm g{k == 5 ? MRG : HB, (const bf16*)(wb + (k == 1 ? W_D1 : (k == 7 ? W_D2 : W_OUT))), M, D, k == 5 ? D : FF};
                pg8::StaticOrder SO; SO.init(M, D, G, bx);
#ifndef SK_RES
                for (int rep_ = 0; rep_ < REP_RES; ++rep_) {
                pg8::EpiRes E{XB, ssp, rep_ + 1 < REP_RES ? 0.0f : (k == 5 ? 1.0f : 0.5f)};
                pg8::gemm_phase<pg8::EpiRes, pg8::StaticOrder, true, true>(lds, g, SO, E);
                }
#endif
            } else if (k == 2) {
                pg8::Gemm g{XB, (const bf16*)(wb + W_IN), M, PW, D};
                pg8::StaticOrder SO; SO.init(M, PW, G, bx);
                pg8::EpiProj E{PROJ, ssp, cs};
#ifndef SK_PROJ
                for (int rep_ = 0; rep_ < REP_PROJ; ++rep_)
                pg8::gemm_phase<pg8::EpiProj, pg8::StaticOrder, true, true>(lds, g, SO, E);
#endif
            } else if (k == 3) {
                float s1 = ((const float*)ap->in[8])[l * 64 + lane] * ((const float*)ap->in[9])[l * 64 + lane];
                float s2 = ((const float*)ap->in[10])[l * 64 + lane] * ((const float*)ap->in[11])[l * 64 + lane];
                s1 = wave_sum(s1); s2 = wave_sum(s2);
                const float lam = expf(s1) - expf(s2) + ap->lam_init[l];
                float* stash = (float*)(ws + WS_STASH);
              for (int rep_ = 0; rep_ < REP_DIFF; ++rep_)
                for (int r = 0; r < 4; ++r) {
                    const int per = G >> 3, xcd = vcu / per, i = vcu % per;
                    const int bh = (xcd * 4 + r) & 31, qb = ((r & 1) ? 31 - i : i) & 31;
#ifndef SK_DIFF
                    if (per == 32 && (G & 7) == 0) at::diff_unit(lds, PROJ, MRG, stash, lam, bh >> 2, bh & 3, qb, bx);
#endif
                }
              if ((G >> 3) != 32 || (G & 7))
                for (int pi = vcu; pi < 512; pi += G)
#pragma unroll 1
                    for (int i = 0; i < 2; ++i) { const int bh = pi >> 4, s_ = pi & 15, qb = i ? 31 - s_ : s_; at::diff_unit(lds, PROJ, MRG, stash, lam, bh >> 2, bh & 3, qb, bx); }
              for (int rep_ = 0; rep_ < REP_DIL; ++rep_)
                at::dil_stream(lds, PROJ, (bf16*)(ws + WS_PART), (f32x2*)(ws + WS_ML), vcu, G, 6144);
                for (int rep_ = 0; rep_ < REP_MISC; ++rep_)
                if (l + 1 < DEPTH) convert_layer(ap, l + 1, lds, gw, ngw, wave, lane);
            } else if (k == 4) {
                const bf16* part = (const bf16*)(ws + WS_PART); const f32x2* ml = (const f32x2*)(ws + WS_ML);
                for (int rep_ = 0; rep_ < REP_MISC; ++rep_)
                for (int row = gw; row < M; row += ngw) {
                    u32x4 pv[3]; f32x2 mv[3];
#pragma unroll
                    for (int b = 0; b < 3; ++b) { pv[b] = *(const u32x4*)(part + ((size_t)b * M + row) * 512 + 8 * lane); mv[b] = ml[((size_t)b * M + row) * 8 + (lane >> 3)]; }
                    const float mall = fmaxf(mv[0].x, fmaxf(mv[1].x, mv[2].x));
                    float w[3], wsum = 0.f;
#pragma unroll
                    for (int b = 0; b < 3; ++b) { w[b] = mv[b].y * __builtin_amdgcn_exp2f(mv[b].x - mall); wsum += w[b]; }
                    const float iw = 1.0f / wsum;
                    float o[8]; float ss = 0.f;
#pragma unroll
                    for (int i = 0; i < 8; ++i) {
                        float acc = 0.f;
#pragma unroll
                        for (int b = 0; b < 3; ++b) { const unsigned wd = pv[b][i >> 1]; acc += w[b] * bf2f((unsigned short)((i & 1) ? (wd >> 16) : (wd & 0xffffu))); }
                        o[i] = acc * iw; ss += o[i] * o[i];
                    }
                    const float rs = __builtin_amdgcn_rsqf(wave_sum(ss) * (1.0f / 512.0f) + 1e-6f);
                    u32x4 wv; wv.x = pk2(o[0] * rs, o[1] * rs); wv.y = pk2(o[2] * rs, o[3] * rs); wv.z = pk2(o[4] * rs, o[5] * rs); wv.w = pk2(o[6] * rs, o[7] * rs);
                    *(u32x4*)(MRG + (size_t)row * D + 512 + 8 * lane) = wv;
                }
            }
        }
        if (ph + 1 < ph_hi) {
            for (int rep_ = 0; rep_ < REP_SYNC; ++rep_) { if (ph == ph_lo) cg::this_grid().sync(); else xcd_barrier(bar); }
        }
    }
}

extern "C" void kernel_launch(void* const* d_in, const int* in_sizes, int n_in, void* d_out, int out_size, void* d_ws, size_t ws_size, hipStream_t stream) {
    static int grid = 0;
    if (grid == 0) {
        if (n_in != 20 || out_size != M * D || ws_size < WS_END) { fprintf(stderr, "kernel_launch: unexpected problem (n_in %d, out %d, ws %zu)\n", n_in, out_size, ws_size); grid = -1; return; }
        int dev = 0, cus = 0, per_cu = 0;
        hipGetDevice(&dev);
        hipDeviceGetAttribute(&cus, hipDeviceAttributeMultiprocessorCount, dev);
        if (hipFuncSetAttribute((const void*)mega, hipFuncAttributeMaxDynamicSharedMemorySize, LDS_BYTES) != hipSuccess) { fprintf(stderr, "kernel_launch: hipFuncSetAttribute failed\n"); grid = -1; return; }
        if (hipOccupancyMaxActiveBlocksPerMultiprocessor(&per_cu, (const void*)mega, NTHR, LDS_BYTES) != hipSuccess || per_cu < 1) { fprintf(stderr, "kernel_launch: occupancy query says %d\n", per_cu); per_cu = 1; (void)hipGetLastError(); }
        grid = cus * per_cu;
    }
    if (grid < 0) return;
    Args a{};
    for (int i = 0; i < 20; ++i) a.in[i] = d_in[i];
    a.out = (float*)d_out; a.ws = (unsigned char*)d_ws;
    a.lam_init[0] = 0.2f; a.lam_init[1] = (float)(0.8 - 0.6 * 0.7408182206817179); a.lam_init[2] = (float)(0.8 - 0.6 * 0.5488116360940264); a.lam_init[3] = (float)(0.8 - 0.6 * 0.4065696597405991);
    constexpr int NPH = 2 + 8 * DEPTH;
#if MK_PER_PHASE
    for (int ph = 0; ph < NPH; ++ph) {
        a.ph_lo = ph; a.ph_hi = ph + 1;
        hipLaunchKernelGGL(mega, dim3(grid), dim3(NTHR), LDS_BYTES, stream, a);
    }
#else
    a.ph_lo = 0; a.ph_hi = NPH;
    if (hipMemsetAsync((char*)d_ws + WS_BAR, 0, BAR_ZERO_BYTES, stream) != hipSuccess) { fprintf(stderr, "kernel_launch: hipMemsetAsync failed\n"); return; }
    void* args[] = {&a};
    hipError_t e = hipLaunchCooperativeKernel((const void*)mega, dim3(grid), dim3(NTHR), args, LDS_BYTES, stream);
    if (e != hipSuccess) fprintf(stderr, "kernel_launch: cooperative launch failed: %s (grid %d)\n", hipGetErrorString(e), grid);
#endif
}
```

```cpp
#include <hip/hip_runtime.h>
#include <hip/hip_cooperative_groups.h>
#include <cstdio>
#include <cstdint>
namespace cg = cooperative_groups;
#ifndef MK_PER_PHASE
#define MK_PER_PHASE 0
#endif
#ifndef REP_DIFF
#define REP_DIFF 1
#endif
#ifndef REP_DIL
#define REP_DIL 1
#endif
#ifndef REP_GU
#define REP_GU 1
#endif
#ifndef REP_PROJ
#define REP_PROJ 1
#endif
#ifndef REP_RES
#define REP_RES 1
#endif
#ifndef REP_MISC
#define REP_MISC 1
#endif
#ifndef REP_SYNC
#define REP_SYNC 1
#endif
namespace pg8 {
#define PG8_LAS __attribute__((address_space(3)))
typedef unsigned short bf16_t;
typedef short bf16x8 __attribute__((ext_vector_type(8)));
typedef float f32x4 __attribute__((ext_vector_type(4)));
typedef unsigned u32x4 __attribute__((ext_vector_type(4)));
constexpr int BM = 256, BK = 64, HALF = 128, HTB = HALF * BK * 2  , STAGE_BYTES = 8 * HTB, NXCD = 8, WGM = 4;

__host__ __device__ __forceinline__ int lds_byte(int r, int c) { const int st = (r >> 4) * 2 + (c >> 5), rr = r & 15, cc = c & 31, ob = rr * 64 + cc * 2; return st * 1024 + (ob ^ (((ob >> 9) & 1) << 5)); }
__host__ __device__ __forceinline__ void stage_rc(int b, int& R, int& C) { const int st = b / 1024, sb = b % 1024, swz = sb ^ (((sb >> 9) & 1) << 5); R = (st >> 1) * 16 + swz / 64; C = (st & 1) * 32 + (swz % 64) / 2; }
__host__ __device__ __forceinline__ int perm32(int rho) { const int n = rho >> 4, i = rho & 15; return 8 * (i >> 2) + 4 * n + (i & 3); }

struct Unit { int pm, pn; };
struct Gemm { const bf16_t* A; const bf16_t* Bt; int M, N, K; };

struct StaticOrder {
    int nM, nN, nwg, G, c;
    __host__ __device__ void init(int M, int N, int G_, int c_) { nM = M / BM; nN = N / BM; nwg = nM * nN; G = G_; c = c_; }
    __host__ __device__ bool next(int i, Unit& u) const {
        const long L = (long)i * G + c; if (L >= nwg) return false;
        int wgid = (int)L; { const int q = nwg / NXCD, r = nwg % NXCD, xcd = wgid % NXCD, off = wgid / NXCD; wgid = (xcd < r ? xcd * (q + 1) : r * (q + 1) + (xcd - r) * q) + off; }
        const int nig = WGM * nN, gid = wgid / nig, fm = gid * WGM, gsz = (nM - fm) < WGM ? (nM - fm) : WGM;
        u.pm = fm + ((wgid % nig) % gsz); u.pn = (wgid % nig) / gsz; return true;
    }
    __device__ __forceinline__ void a_ready(const Unit&) const {}
    __device__ __forceinline__ void done(const Unit&) const {}
};
__device__ __forceinline__ unsigned cvt_pk_bf16(float lo, float hi) { unsigned r; asm volatile("v_cvt_pk_bf16_f32 %0, %1, %2" : "=v"(r) : "v"(lo), "v"(hi)); return r; }
typedef float f32x2 __attribute__((ext_vector_type(2)));
typedef unsigned u32x2 __attribute__((ext_vector_type(2)));
constexpr int NSSP = 16;
__device__ __forceinline__ void rows_rstd(float (&rs)[8], const float* ssp, int row0, int fq, float mul) {
    f32x4 v[8];
#pragma unroll
    for (int j = 0; j < 8; ++j) v[j] = ((const f32x4*)(ssp + (size_t)(row0 + (j >> 2) * HALF + (j & 3) * 16) * NSSP))[fq];
#pragma unroll
    for (int j = 0; j < 8; ++j) {
        float t = (v[j][0] + v[j][1]) + (v[j][2] + v[j][3]);
        t += __shfl_xor(t, 16); t += __shfl_xor(t, 32);
        rs[j] = mul * __builtin_amdgcn_rsqf(t * (1.0f / 1024.0f) + 1e-6f);
    }
}
struct EpiGU {
    static constexpr bool PERM = true, AFTER_DRAIN = false;
    bf16_t* H; const float* ssp; int ldh;
    __device__ __forceinline__ void operator()(const f32x4 (&acc)[2][2][4][2], const Unit& u, int wr, int wc, int fr_, int fq_) const {
        int fr = fr_, fq = fq_; asm volatile("" : "+v"(fr), "+v"(fq));
        const int row0 = u.pm * BM + wr * 64 + fr, col0 = u.pn * HALF + wc * 32 + 8 * fq;
        float rsv[8]; rows_rstd(rsv, ssp, row0, fq, 1.0f);
#pragma unroll
        for (int ai = 0; ai < 2; ++ai)
#pragma unroll
            for (int m = 0; m < 4; ++m) {
                const int row = row0 + ai * HALF + m * 16;
                const float rs = rsv[ai * 4 + m], rsn = -1.4426950408889634f * rs, rs2 = rs * rs;
                f32x2 t[4], ab[4];
#pragma unroll
                for (int q = 0; q < 4; ++q) {
                    const f32x2 a2 = (f32x2){acc[ai][0][m][q >> 1][(2 * q) & 3], acc[ai][0][m][q >> 1][(2 * q + 1) & 3]};
                    const f32x2 b2 = (f32x2){acc[ai][1][m][q >> 1][(2 * q) & 3], acc[ai][1][m][q >> 1][(2 * q + 1) & 3]};
                    t[q] = a2 * rsn; ab[q] = (a2 * b2) * rs2;
                }
#pragma unroll
                for (int q = 0; q < 4; ++q) { t[q].x = __builtin_amdgcn_exp2f(t[q].x); t[q].y = __builtin_amdgcn_exp2f(t[q].y); }
#pragma unroll
                for (int q = 0; q < 4; ++q) t[q] = t[q] + 1.0f;
#pragma unroll
                for (int q = 0; q < 4; ++q) { t[q].x = __builtin_amdgcn_rcpf(t[q].x); t[q].y = __builtin_amdgcn_rcpf(t[q].y); }
#pragma unroll
                for (int q = 0; q < 4; ++q) ab[q] = ab[q] * t[q];
                u32x4 w; w.x = cvt_pk_bf16(ab[0].x, ab[0].y); w.y = cvt_pk_bf16(ab[1].x, ab[1].y); w.z = cvt_pk_bf16(ab[2].x, ab[2].y); w.w = cvt_pk_bf16(ab[3].x, ab[3].y);
                *(u32x4*)(H + (size_t)row * ldh + col0) = w;
            }
    }
};
struct EpiRes {
    static constexpr bool PERM = true, AFTER_DRAIN = false;
    bf16_t* XB; float* ssp; float scale;
    __device__ __forceinline__ void operator()(const f32x4 (&acc)[2][2][4][2], const Unit& u, int wr, int wc, int fr_, int fq_) const {
        int fr = fr_, fq = fq_; asm volatile("" : "+v"(fr), "+v"(fq));
        const int row0 = u.pm * BM + wr * 64 + fr, col0 = u.pn * BM + wc * 32 + 8 * fq;
#pragma unroll
        for (int ai = 0; ai < 2; ++ai) {
            u32x4 xv[4][2];
#pragma unroll
            for (int m = 0; m < 4; ++m)
#pragma unroll
                for (int bj = 0; bj < 2; ++bj) xv[m][bj] = *(const u32x4*)(XB + (size_t)(row0 + ai * HALF + m * 16) * 1024 + col0 + bj * HALF);
#pragma unroll
            for (int m = 0; m < 4; ++m) {
                const int row = row0 + ai * HALF + m * 16;
                float ss = 0.f;
#pragma unroll
                for (int bj = 0; bj < 2; ++bj) {
                    float o[8];
#pragma unroll
                    for (int q = 0; q < 4; ++q) {
                        const unsigned wd = xv[m][bj][q];
                        const float x0 = __builtin_bit_cast(float, wd << 16), x1 = __builtin_bit_cast(float, wd & 0xffff0000u);
                        o[2 * q] = x0 + acc[ai][bj][m][q >> 1][(2 * q) & 3] * scale;
                        o[2 * q + 1] = x1 + acc[ai][bj][m][q >> 1][(2 * q + 1) & 3] * scale;
                    }
#pragma unroll
                    for (int q = 0; q < 8; ++q) ss += o[q] * o[q];
                    u32x4 w; w.x = cvt_pk_bf16(o[0], o[1]); w.y = cvt_pk_bf16(o[2], o[3]); w.z = cvt_pk_bf16(o[4], o[5]); w.w = cvt_pk_bf16(o[6], o[7]);
                    *(u32x4*)(XB + (size_t)row * 1024 + col0 + bj * HALF) = w;
                }
                ss += __shfl_xor(ss, 16); ss += __shfl_xor(ss, 32);
                if (fq == 0) ssp[(size_t)row * NSSP + u.pn * 4 + wc] = ss;
            }
            asm volatile("" ::: "memory");
        }
    }
};
struct EpiProj {
    static constexpr bool PERM = true, AFTER_DRAIN = false;
    bf16_t* P; const float* ssp; const float* cs;
    __device__ __forceinline__ void operator()(const f32x4 (&acc)[2][2][4][2], const Unit& u, int wr, int wc, int fr_, int fq_) const {
        int fr = fr_, fq = fq_; asm volatile("" : "+v"(fr), "+v"(fq));
        const int row0 = u.pm * BM + wr * 64 + fr;
        const int t = u.pn;
        const bool rope = !(t == 4 || t == 5 || t == 10 || t == 11);
        const float qs = (t < 2 || t == 6 || t == 7) ? 0.125f * 1.4426950408889634f : 1.0f;
        const int colL = t * BM + wc * 64 + 8 * fq;
        float rsv[8]; rows_rstd(rsv, ssp, row0, fq, qs);
#pragma unroll
        for (int hb = 0; hb < 4; ++hb) {
            const int ai = hb >> 1;
            f32x4 cv[2][4];
            if (rope) {
#pragma unroll
                for (int mm = 0; mm < 2; ++mm) {
                    const int m = (hb & 1) * 2 + mm;
                    const float* cp = cs + (size_t)((row0 + ai * HALF + m * 16) & 8191) * 64 + 8 * fq;
                    cv[mm][0] = *(const f32x4*)(cp); cv[mm][1] = *(const f32x4*)(cp + 4); cv[mm][2] = *(const f32x4*)(cp + 32); cv[mm][3] = *(const f32x4*)(cp + 36);
                }
            }
#pragma unroll
            for (int mm = 0; mm < 2; ++mm) {
                const int m = (hb & 1) * 2 + mm;
                const int row = row0 + ai * HALF + m * 16;
                const float rs = rsv[ai * 4 + m];
                float o1[8], o2[8];
                if (rope) {
                    const f32x4 c0 = cv[mm][0], c1 = cv[mm][1], s0 = cv[mm][2], s1 = cv[mm][3];
#pragma unroll
                    for (int i = 0; i < 4; ++i) {
                        const float a0 = acc[ai][0][m][0][i] * rs, b0 = acc[ai][1][m][0][i] * rs, a1 = acc[ai][0][m][1][i] * rs, b1 = acc[ai][1][m][1][i] * rs;
                        o1[i] = a0 * c0[i] - b0 * s0[i]; o2[i] = a0 * s0[i] + b0 * c0[i];
                        o1[4 + i] = a1 * c1[i] - b1 * s1[i]; o2[4 + i] = a1 * s1[i] + b1 * c1[i];
                    }
                } else {
#pragma unroll
                    for (int i = 0; i < 4; ++i) { o1[i] = acc[ai][0][m][0][i] * rs; o1[4 + i] = acc[ai][0][m][1][i] * rs; o2[i] = acc[ai][1][m][0][i] * rs; o2[4 + i] = acc[ai][1][m][1][i] * rs; }
                }
                u32x4 w1, w2;
                w1.x = cvt_pk_bf16(o1[0], o1[1]); w1.y = cvt_pk_bf16(o1[2], o1[3]); w1.z = cvt_pk_bf16(o1[4], o1[5]); w1.w = cvt_pk_bf16(o1[6], o1[7]);
                w2.x = cvt_pk_bf16(o2[0], o2[1]); w2.y = cvt_pk_bf16(o2[2], o2[3]); w2.z = cvt_pk_bf16(o2[4], o2[5]); w2.w = cvt_pk_bf16(o2[6], o2[7]);
                bf16_t* pr = P + (size_t)row * 3072 + colL;
                *(u32x4*)(pr) = w1; *(u32x4*)(pr + 32) = w2;
            }
            asm volatile("" ::: "memory");
        }
    }
};
template <class Epi, class Sched, bool ALIGN_EPI = false, bool SP2 = false>
__device__ __forceinline__ void gemm_phase(PG8_LAS unsigned char* lds, const Gemm g, const Sched& S, const Epi& E) {
    int tid_ = threadIdx.x; asm volatile("" : "+v"(tid_));
    const int tid = tid_, wid = __builtin_amdgcn_readfirstlane(tid >> 6), lane = tid & 63, wr = wid >> 2, wc = wid & 3, fr = lane & 15, fq = lane >> 4;
    const int K = g.K, nt = K / BK;
    unsigned voffA[2], voffB[2];
#pragma unroll
    for (int i = 0; i < 2; ++i) { int R, C; stage_rc(tid * 16 + i * 8192, R, C); const int Rb = Epi::PERM ? ((R & ~31) + perm32(R & 31)) : R;
        voffA[i] = (unsigned)(R * K + C) * 2u; voffB[i] = (unsigned)(Rb * K + C) * 2u; }
    const size_t kstep = (size_t)(BK * 2);
    const size_t hstep = (size_t)HALF * K * 2;
    const size_t tstep = 2 * hstep;
    const unsigned ldsw = (unsigned)wid * 1024u;
    const int aoff = lds_byte(wr * 64 + fr, fq * 8), boff = lds_byte(wc * 32 + fr, fq * 8);
#define PG8_SA(b, h) (((b) * 2 + (h)) * HTB)
#define PG8_SB(b, h) ((4 + (b) * 2 + (h)) * HTB)
#define PG8_STAGE(bufoff, gbase, voff) do { _Pragma("unroll") for (int _i = 0; _i < 2; ++_i) \
        __builtin_amdgcn_global_load_lds((const unsigned*)((const char*)(gbase) + (voff)[_i]), (PG8_LAS unsigned*)(lds + (bufoff) + ldsw + _i * 8192), 16, 0, 0); } while (0)
#define PG8_LDA(dst, b, h) do { _Pragma("unroll") for (int m = 0; m < 4; ++m) _Pragma("unroll") for (int k = 0; k < 2; ++k) dst[m][k] = *(const PG8_LAS bf16x8*)(lds + PG8_SA(b, h) + aoff + m * 2048 + k * 1024); } while (0)
#define PG8_LDB(dst, b, h) do { _Pragma("unroll") for (int n = 0; n < 2; ++n) _Pragma("unroll") for (int k = 0; k < 2; ++k) dst[n][k] = *(const PG8_LAS bf16x8*)(lds + PG8_SB(b, h) + boff + n * 2048 + k * 1024); } while (0)
#define PG8_MMA(ai, bj, At, Bt) do { __builtin_amdgcn_s_setprio(1); _Pragma("unroll") for (int m = 0; m < 4; ++m) _Pragma("unroll") for (int n = 0; n < 2; ++n) _Pragma("unroll") for (int k = 0; k < 2; ++k) \
        acc[ai][bj][m][n] = __builtin_amdgcn_mfma_f32_16x16x32_bf16(Bt[n][k], At[m][k], acc[ai][bj][m][n], 0, 0, 0); __builtin_amdgcn_s_setprio(0); } while (0)
#define PG8_WAIT_V(n) asm volatile("s_waitcnt vmcnt(" #n ")" ::: "memory")
#define PG8_WAIT_L(n) asm volatile("s_waitcnt lgkmcnt(" #n ")" ::: "memory")
#define PG8_BAR __builtin_amdgcn_s_barrier()
#define PG8_SCHED __builtin_amdgcn_sched_barrier(0)
    Unit cur, nxt; int ui = 0;
    if (!S.next(0, cur)) return;
    f32x4 acc[2][2][4][2];
#pragma unroll
    for (int a = 0; a < 2; ++a)
#pragma unroll
        for (int b = 0; b < 2; ++b)
#pragma unroll
            for (int m = 0; m < 4; ++m)
#pragma unroll
                for (int n = 0; n < 2; ++n) acc[a][b][m][n] = (f32x4){0.f, 0.f, 0.f, 0.f};
    bf16x8 At[4][2], B0[2][2], B1[2][2];
    const char* cA = (const char*)g.A + (size_t)cur.pm * tstep; const char* cB = (const char*)g.Bt + (size_t)cur.pn * tstep;
    S.a_ready(cur);
    if constexpr (SP2) {
        PG8_STAGE(PG8_SB(0, 0), cB, voffB); PG8_STAGE(PG8_SB(0, 1), cB + hstep, voffB); PG8_STAGE(PG8_SA(0, 0), cA, voffA); PG8_STAGE(PG8_SA(0, 1), cA + hstep, voffA);
        if (wr == 1) PG8_BAR;
        PG8_WAIT_V(2); PG8_BAR;
        PG8_STAGE(PG8_SB(1, 0), cB + kstep, voffB); PG8_STAGE(PG8_SA(1, 0), cA + kstep, voffA); PG8_STAGE(PG8_SB(1, 1), cB + hstep + kstep, voffB);
        PG8_WAIT_V(6); PG8_BAR;
    } else {
        PG8_STAGE(PG8_SB(0, 0), cB, voffB); PG8_STAGE(PG8_SA(0, 0), cA, voffA); PG8_STAGE(PG8_SB(0, 1), cB + hstep, voffB); PG8_STAGE(PG8_SA(0, 1), cA + hstep, voffA);
        if (wr == 1) PG8_BAR;
        PG8_WAIT_V(4); PG8_BAR;
        PG8_STAGE(PG8_SB(1, 0), cB + kstep, voffB); PG8_STAGE(PG8_SA(1, 0), cA + kstep, voffA); PG8_STAGE(PG8_SB(1, 1), cB + hstep + kstep, voffB);
        PG8_WAIT_V(6); PG8_BAR;
    }
    for (;;) {
        const bool has_next = S.next(ui + 1, nxt);
        const char* nA = has_next ? (const char*)g.A + (size_t)nxt.pm * tstep : cA; const char* nB = has_next ? (const char*)g.Bt + (size_t)nxt.pn * tstep : cB;
        for (int t = 0; t < nt; t += 2) {
            const bool last = (t == nt - 2);
            const char* a1 = cA + (size_t)(t + 1) * kstep;
            const char* a2 = last ? nA : cA + (size_t)(t + 2) * kstep; const char* b2 = last ? nB : cB + (size_t)(t + 2) * kstep;
            const char* a3 = a2 + kstep; const char* b3 = b2 + kstep;
            if (last && has_next) S.a_ready(nxt);
            if constexpr (SP2) {
            PG8_LDB(B0, 0, 0); PG8_LDB(B1, 0, 1); PG8_SCHED; PG8_LDA(At, 0, 0); PG8_STAGE(PG8_SA(1, 1), a1 + hstep, voffA);
            PG8_WAIT_V(8); PG8_WAIT_L(0); PG8_BAR; PG8_MMA(0, 0, At, B0); PG8_MMA(0, 1, At, B1); PG8_BAR; PG8_SCHED;
            PG8_LDA(At, 0, 1); PG8_STAGE(PG8_SB(0, 0), b2, voffB); PG8_STAGE(PG8_SB(0, 1), b2 + hstep, voffB); PG8_STAGE(PG8_SA(0, 0), a2, voffA);
            PG8_WAIT_V(8); PG8_WAIT_L(0); PG8_BAR; PG8_MMA(1, 0, At, B0); PG8_MMA(1, 1, At, B1); PG8_BAR; PG8_SCHED;
            PG8_LDB(B0, 1, 0); PG8_LDB(B1, 1, 1); PG8_SCHED; PG8_LDA(At, 1, 0); PG8_STAGE(PG8_SA(0, 1), a2 + hstep, voffA);
            PG8_WAIT_V(8); PG8_WAIT_L(0); PG8_BAR; PG8_MMA(0, 0, At, B0); PG8_MMA(0, 1, At, B1); PG8_BAR; PG8_SCHED;
            PG8_LDA(At, 1, 1); PG8_STAGE(PG8_SB(1, 0), b3, voffB); PG8_STAGE(PG8_SB(1, 1), b3 + hstep, voffB); PG8_STAGE(PG8_SA(1, 0), a3, voffA);
            PG8_WAIT_V(8); PG8_WAIT_L(0); PG8_BAR; PG8_MMA(1, 0, At, B0); PG8_MMA(1, 1, At, B1); PG8_BAR; PG8_SCHED;
            } else {
            PG8_LDB(B0, 0, 0); PG8_SCHED; PG8_LDA(At, 0, 0); PG8_STAGE(PG8_SA(1, 1), a1 + hstep, voffA);
            PG8_WAIT_L(8); PG8_BAR; PG8_WAIT_L(0); PG8_MMA(0, 0, At, B0); PG8_BAR; PG8_SCHED;
            PG8_LDB(B1, 0, 1); PG8_STAGE(PG8_SB(0, 0), b2, voffB);
            PG8_BAR; PG8_WAIT_L(0); PG8_MMA(0, 1, At, B1); PG8_BAR;
            PG8_LDA(At, 0, 1); PG8_STAGE(PG8_SA(0, 0), a2, voffA);
            PG8_BAR; PG8_WAIT_L(0); PG8_MMA(1, 0, At, B0); PG8_BAR; PG8_SCHED;
            PG8_STAGE(PG8_SB(0, 1), b2 + hstep, voffB);
            PG8_WAIT_V(6); PG8_BAR; PG8_MMA(1, 1, At, B1); PG8_BAR;
            PG8_LDB(B0, 1, 0); PG8_SCHED; PG8_LDA(At, 1, 0); PG8_STAGE(PG8_SA(0, 1), a2 + hstep, voffA);
            PG8_WAIT_L(8); PG8_BAR; PG8_WAIT_L(0); PG8_MMA(0, 0, At, B0); PG8_BAR; PG8_SCHED;
            PG8_LDB(B1, 1, 1); PG8_STAGE(PG8_SB(1, 0), b3, voffB);
            PG8_BAR; PG8_WAIT_L(0); PG8_MMA(0, 1, At, B1); PG8_BAR;
            PG8_LDA(At, 1, 1); PG8_STAGE(PG8_SA(1, 0), a3, voffA);
            PG8_BAR; PG8_WAIT_L(0); PG8_MMA(1, 0, At, B0); PG8_BAR; PG8_SCHED;
            PG8_STAGE(PG8_SB(1, 1), b3 + hstep, voffB);
            PG8_WAIT_V(6); PG8_BAR; PG8_MMA(1, 1, At, B1); PG8_BAR;
            }
        }
        if constexpr (ALIGN_EPI) { if (wr == 0) PG8_BAR; }
        if constexpr (!Epi::AFTER_DRAIN) { E(acc, cur, wr, wc, fr, fq); S.done(cur); }
        if (!has_next) break;
#pragma unroll
        for (int a = 0; a < 2; ++a)
#pragma unroll
            for (int b = 0; b < 2; ++b)
#pragma unroll
                for (int m = 0; m < 4; ++m)
#pragma unroll
                    for (int n = 0; n < 2; ++n) acc[a][b][m][n] = (f32x4){0.f, 0.f, 0.f, 0.f};
        cur = nxt; cA = nA; cB = nB; ++ui;
        if constexpr (ALIGN_EPI) { if (wr == 1) PG8_BAR; }
    }
    PG8_WAIT_V(0);
    if constexpr (!ALIGN_EPI) { if (wr == 0) PG8_BAR; }
    PG8_BAR;
    if constexpr (Epi::AFTER_DRAIN) { E.fused(acc, cur, wr, wc, fr, fq, lds, wid, lane); S.done(cur); }
#undef PG8_SA
#undef PG8_SB
#undef PG8_STAGE
#undef PG8_LDA
#undef PG8_LDB
#undef PG8_MMA
#undef PG8_WAIT_V
#undef PG8_WAIT_L
#undef PG8_BAR
#undef PG8_SCHED
}
}

constexpr int NB = 8, S = 8192, D = 1024, FF = 2816, PW = 3072, M = NB * S, DEPTH = 4;
constexpr int NWAVES = 8, NTHR = 512;
#define LAS __attribute__((address_space(3)))
typedef unsigned short bf16;
typedef float f32x4 __attribute__((ext_vector_type(4)));
typedef float f32x2 __attribute__((ext_vector_type(2)));
typedef unsigned u32x4 __attribute__((ext_vector_type(4)));
typedef unsigned u32x2 __attribute__((ext_vector_type(2)));

__device__ __forceinline__ int ltid() { int t = threadIdx.x; asm volatile("" : "+v"(t)); return t; }
namespace at {
typedef short bf16x8 __attribute__((ext_vector_type(8)));
typedef short s16x4 __attribute__((ext_vector_type(4)));
typedef float f32x16 __attribute__((ext_vector_type(16)));
constexpr int KROW = 144, KBUF = 64 * KROW, VBUF = 16384, ATT_LDS = 2 * KBUF + 2 * VBUF;
constexpr float NEGF = -1e30f;
__device__ __forceinline__ unsigned cvtpk(float lo, float hi) { typedef __bf16 b2 __attribute__((ext_vector_type(2))); f32x2 v = {lo, hi}; b2 b = __builtin_convertvector(v, b2); return __builtin_bit_cast(unsigned, b); }
__device__ __forceinline__ float max3f(float a, float b, float c) { float r; asm("v_max3_f32 %0, %1, %2, %3" : "=v"(r) : "v"(a), "v"(b), "v"(c)); return r; }
__device__ __forceinline__ float partner_max(float v) { auto rr = __builtin_amdgcn_permlane32_swap(__float_as_uint(v), __float_as_uint(v), false, false); return fmaxf(__uint_as_float(rr[0]), __uint_as_float(rr[1])); }
__device__ __forceinline__ float partner_sum(float v) { auto rr = __builtin_amdgcn_permlane32_swap(__float_as_uint(v), __float_as_uint(v), false, false); return __uint_as_float(rr[0]) + __uint_as_float(rr[1]); }
__device__ __forceinline__ s16x4 vtr(const LAS unsigned char* p) { typedef short v4i16_t __attribute__((ext_vector_type(4))); return __builtin_bit_cast(s16x4, __builtin_amdgcn_ds_read_tr16_b64_v4i16((LAS v4i16_t*)p)); }
__device__ __forceinline__ bf16x8 pack8(const f32x16& p, int b) {
    u32x4 w; w.x = cvtpk(p[b], p[b + 1]); w.y = cvtpk(p[b + 2], p[b + 3]); w.z = cvtpk(p[b + 4], p[b + 5]); w.w = cvtpk(p[b + 6], p[b + 7]); return __builtin_bit_cast(bf16x8, w);
}

template <int DV>
__device__ __forceinline__ void sweep(LAS unsigned char* lds, const bf16* Kb, const bf16* Vb, size_t rstride, int t_lo, int t_hi, int W, int ql, int wq_lo,
                                      const bf16x8 (&qf)[4], f32x16 (&o)[DV / 32], float& m, float& l) {
    constexpr int NV = DV / 64, ND = DV / 32;
    const int tid = ltid(), lane = tid & 63, r32 = lane & 31, hi = lane >> 5;
    const int krow = tid >> 3, kch = tid & 7;
    const bf16* kg = Kb + (size_t)krow * rstride + kch * 8;
    const int kwoff = krow * KROW + kch * 16;
    const int vrow0 = (DV == 64) ? ((tid >> 4) * 2 + ((tid >> 2) & 1)) : ((tid >> 5) * 2 + ((tid >> 2) & 1));
    const int vch = (DV == 64) ? (((tid >> 3) & 1) * 4 + (tid & 3)) : (((tid >> 3) & 3) * 4 + (tid & 3));
    const bf16* vg = Vb + (size_t)vrow0 * rstride + vch * 8;
    int vwoff[NV];
#pragma unroll
    for (int i = 0; i < NV; ++i) { const int vr = vrow0 + 32 * i; vwoff[i] = (vch >> 2) * 4096 + (vr >> 4) * 1024 + (vr & 15) * 64 + (vch & 3) * 16; }
    const size_t tstep = (size_t)64 * rstride;
    u32x4 kregA, vregA[NV], kregB, vregB[NV];
#define AT_LOAD(KR_, VR_, T_) do { KR_ = *(const u32x4*)(kg + (size_t)(T_) * tstep); \
        _Pragma("unroll") for (int i = 0; i < NV; ++i) VR_[i] = *(const u32x4*)(vg + (size_t)(T_) * tstep + (size_t)(32 * i) * rstride); } while (0)
#define AT_WRITE(KR_, VR_) do { *(LAS u32x4*)(kbuf + kwoff) = KR_; \
        _Pragma("unroll") for (int i = 0; i < NV; ++i) *(LAS u32x4*)(vbuf + vwoff[i]) = VR_[i]; } while (0)
    AT_LOAD(kregA, vregA, t_lo);
    if (t_lo + 1 < t_hi) AT_LOAD(kregB, vregB, t_lo + 1);
    const int kroff = r32 * KROW + hi * 16;
    const int vroff = (4 * hi + ((lane & 15) >> 2)) * 64 + ((lane >> 4) & 1) * 32 + (lane & 3) * 8;
    f32x16 negm;
#pragma unroll
    for (int r = 0; r < 16; ++r) negm[r] = -m;
#define AT_TILE() do { \
        const int k0 = t * 64; \
        const bool relevant = (k0 <= wq_lo + 31) && (wq_lo - (k0 + 63) <= W); \
        if (relevant) { \
            bf16x8 kf[8]; \
_Pragma("unroll") \
            for (int d0 = 0; d0 < 4; ++d0) { kf[2 * d0] = *(const LAS bf16x8*)(kbuf + kroff + d0 * 32); kf[2 * d0 + 1] = *(const LAS bf16x8*)(kbuf + kroff + 32 * KROW + d0 * 32); } \
            f32x16 p0, p1; \
            p0 = __builtin_amdgcn_mfma_f32_32x32x16_bf16(kf[0], qf[0], negm, 0, 0, 0); \
            p1 = __builtin_amdgcn_mfma_f32_32x32x16_bf16(kf[1], qf[0], negm, 0, 0, 0); \
_Pragma("unroll") \
            for (int d0 = 1; d0 < 4; ++d0) { \
                p0 = __builtin_amdgcn_mfma_f32_32x32x16_bf16(kf[2 * d0], qf[d0], p0, 0, 0, 0); \
                p1 = __builtin_amdgcn_mfma_f32_32x32x16_bf16(kf[2 * d0 + 1], qf[d0], p1, 0, 0, 0); \
            } \
 \
            s16x4 vlo[2][4], vhh[2][4]; \
_Pragma("unroll") \
            for (int ks = 0; ks < 4; ++ks) { vlo[0][ks] = vtr(vbuf + vroff + ks * 1024); vhh[0][ks] = vtr(vbuf + vroff + ks * 1024 + 512); } \
            __builtin_amdgcn_sched_barrier(0); \
            const bool full = (k0 + 63 <= wq_lo) && (wq_lo + 31 - k0 <= W); \
            if (!full) { \
_Pragma("unroll") \
                for (int r = 0; r < 16; ++r) { \
                    const int kv = k0 + (r & 3) + 8 * (r >> 2) + 4 * hi; \
                    const bool v0 = (kv <= ql) && (ql - kv <= W), v1 = (kv + 32 <= ql) && (ql - kv - 32 <= W); \
                    p0[r] = v0 ? p0[r] : NEGF; p1[r] = v1 ? p1[r] : NEGF; \
                } \
            } \
            asm volatile("s_nop 15\n\ts_nop 7" : "+v"(p0), "+v"(p1)); \
            float rm; \
            { float a = max3f(p0[0], p0[1], p1[0]), b = max3f(p0[2], p0[3], p1[1]); a = max3f(a, p1[2], p1[3]); \
_Pragma("unroll") \
              for (int r = 4; r < 16; r += 4) { a = max3f(a, p0[r], p0[r + 1]); b = max3f(b, p0[r + 2], p0[r + 3]); a = max3f(a, p1[r], p1[r + 1]); b = max3f(b, p1[r + 2], p1[r + 3]); } \
              rm = fmaxf(a, b); } \
            rm = partner_max(rm); \
            if (__builtin_expect(__any(rm > 8.0f), 0)) { \
                const float dl = fmaxf(rm, 0.f); \
                m += dl; \
_Pragma("unroll") \
                for (int r = 0; r < 16; ++r) { p0[r] -= dl; p1[r] -= dl; negm[r] = -m; } \
                const float f = __builtin_amdgcn_exp2f(-dl); \
                l *= f; \
_Pragma("unroll") \
                for (int d = 0; d < ND; ++d) o[d] = o[d] * f; \
            } \
            float s0 = 0.f, s1 = 0.f; \
_Pragma("unroll") \
            for (int r = 0; r < 16; ++r) { p0[r] = __builtin_amdgcn_exp2f(p0[r]); p1[r] = __builtin_amdgcn_exp2f(p1[r]); s0 += p0[r]; asm volatile("" : "+v"(s0)); s1 += p1[r]; asm volatile("" : "+v"(s1)); } \
            l += s0 + s1; \
            bf16x8 pa[4]; \
            pa[0] = pack8(p0, 0); pa[1] = pack8(p0, 8); pa[2] = pack8(p1, 0); pa[3] = pack8(p1, 8); \
_Pragma("unroll") \
            for (int d = 0; d < ND; ++d) { \
                if (d + 1 < ND) { \
_Pragma("unroll") \
                    for (int ks = 0; ks < 4; ++ks) { vlo[(d + 1) & 1][ks] = vtr(vbuf + vroff + (d + 1) * 4096 + ks * 1024); vhh[(d + 1) & 1][ks] = vtr(vbuf + vroff + (d + 1) * 4096 + ks * 1024 + 512); } \
                } \
_Pragma("unroll") \
                for (int ks = 0; ks < 4; ++ks) { \
                    const s16x4 lo = vlo[d & 1][ks], hh = vhh[d & 1][ks]; \
                    const bf16x8 vf = (bf16x8){lo[0], lo[1], lo[2], lo[3], hh[0], hh[1], hh[2], hh[3]}; \
                    o[d] = __builtin_amdgcn_mfma_f32_32x32x16_bf16(vf, pa[ks], o[d], 0, 0, 0); \
                } \
                if (d + 1 < ND) __builtin_amdgcn_sched_barrier(0); \
            } \
        } \
    } while (0)

    for (int tt = t_lo, st = 0; tt < t_hi; tt += 2, ++st) {
        LAS unsigned char* kb0 = lds + (st & 1) * 2 * KBUF;
        LAS unsigned char* vb0 = lds + 4 * KBUF + (st & 1) * 2 * VBUF;
        { LAS unsigned char* kbuf = kb0; LAS unsigned char* vbuf = vb0; AT_WRITE(kregA, vregA); }
        { LAS unsigned char* kbuf = kb0 + KBUF; LAS unsigned char* vbuf = vb0 + VBUF; AT_WRITE(kregB, vregB); }
        __syncthreads();
        if (tt + 2 < t_hi) { AT_LOAD(kregA, vregA, tt + 2); AT_LOAD(kregB, vregB, tt + 3); }
        { LAS unsigned char* kbuf = kb0; LAS unsigned char* vbuf = vb0; const int t = tt; AT_TILE(); }
        { LAS unsigned char* kbuf = kb0 + KBUF; LAS unsigned char* vbuf = vb0 + VBUF; const int t = tt + 1; AT_TILE(); }
    }
#undef AT_LOAD
#undef AT_WRITE
    __syncthreads();
}

__device__ __forceinline__ void diff_unit(LAS unsigned char* lds, const bf16* proj, bf16* merged, float* stash, float lam, int b, int h, int qb, int blk) {
    const int tid = ltid(), lane = tid & 63, r32 = lane & 31, hi = lane >> 5;
    const int wid = __builtin_amdgcn_readfirstlane(tid >> 6);
    const size_t rowbase = (size_t)b * S;
    const int wq_lo = qb * 256 + wid * 32, ql = wq_lo + r32;
    const bf16* qrow = proj + (rowbase + ql) * PW + h * 128;
    const bf16* kb = proj + rowbase * PW + 512 + h * 128;
    const bf16* vb = proj + rowbase * PW + 1024 + h * 128;
    float* st = stash + ((size_t)blk * NTHR + tid) * 64;
    f32x16 o[4]; float inv = 0.f;
#pragma unroll 1
    for (int comp = 0; comp < 2; ++comp) {
        bf16x8 qf[4];
#pragma unroll
        for (int d0 = 0; d0 < 4; ++d0) qf[d0] = *(const bf16x8*)(qrow + comp * 64 + 16 * d0 + 8 * hi);
#pragma unroll
        for (int d = 0; d < 4; ++d) o[d] = (f32x16){};
        float m = 0.f, l = 0.f;
        sweep<128>(lds, kb + comp * 64, vb, (size_t)PW, 0, 4 * qb + 4, 1 << 30, ql, wq_lo, qf, o, m, l);
        l = partner_sum(l);
        inv = 1.0f / l;
        if (comp == 0) {
#pragma unroll
            for (int d = 0; d < 4; ++d)
#pragma unroll
                for (int r4 = 0; r4 < 4; ++r4)
                    *(f32x4*)(st + d * 16 + r4 * 4) = (f32x4){o[d][4 * r4] * inv, o[d][4 * r4 + 1] * inv, o[d][4 * r4 + 2] * inv, o[d][4 * r4 + 3] * inv};
        }
    }
    float ss = 0.f;
    const float li = lam * inv;
#pragma unroll
    for (int d = 0; d < 4; ++d)
#pragma unroll
        for (int r4 = 0; r4 < 4; ++r4) {
            const f32x4 s1 = *(const f32x4*)(st + d * 16 + r4 * 4);
#pragma unroll
            for (int i = 0; i < 4; ++i) { const float v = s1[i] - li * o[d][4 * r4 + i]; o[d][4 * r4 + i] = v; ss += v * v; }
        }
    ss = partner_sum(ss);
    const float rs = __builtin_amdgcn_rsqf(ss * (1.0f / 128.0f) + 1e-5f);
    bf16* orow = merged + (rowbase + ql) * D + h * 128 + 4 * hi;
#pragma unroll
    for (int d = 0; d < 4; ++d)
#pragma unroll
        for (int r4 = 0; r4 < 4; ++r4) {
            u32x2 w; w.x = cvtpk(o[d][4 * r4] * rs, o[d][4 * r4 + 1] * rs); w.y = cvtpk(o[d][4 * r4 + 2] * rs, o[d][4 * r4 + 3] * rs);
            *(u32x2*)(orow + 32 * d + 8 * r4) = w;
        }
}

__device__ __forceinline__ void dil_unit(LAS unsigned char* lds, const bf16* proj, bf16* part, f32x2* ml, int b, int head, int dil, int res, int lblk) {
    const int tid = ltid(), lane = tid & 63, r32 = lane & 31, hi = lane >> 5;
    const int wid = __builtin_amdgcn_readfirstlane(tid >> 6);
    const int wq_lo = lblk * 256 + wid * 32, ql = wq_lo + r32;
    const size_t row = (size_t)b * S + (size_t)ql * dil + res;
    const bf16* qrow = proj + row * PW + 1536 + head * 64;
    const bf16* kb = proj + ((size_t)b * S + res) * PW + 2048 + head * 64;
    const bf16* vb = proj + ((size_t)b * S + res) * PW + 2560 + head * 64;
    bf16x8 qf[4];
#pragma unroll
    for (int d0 = 0; d0 < 4; ++d0) qf[d0] = *(const bf16x8*)(qrow + 16 * d0 + 8 * hi);
    f32x16 o[2]; o[0] = (f32x16){}; o[1] = (f32x16){};
    float m = 0.f, l = 0.f;
    const int t_lo = (4 * lblk - 2) > 0 ? (4 * lblk - 2) : 0;
    sweep<64>(lds, kb, vb, (size_t)dil * PW, t_lo, 4 * lblk + 4, 128, ql, wq_lo, qf, o, m, l);
    l = partner_sum(l);
    const float inv = 1.0f / l;
    bf16* orow = part + row * 512 + head * 64 + 4 * hi;
#pragma unroll
    for (int d = 0; d < 2; ++d)
#pragma unroll
        for (int r4 = 0; r4 < 4; ++r4) {
            u32x2 w; w.x = cvtpk(o[d][4 * r4] * inv, o[d][4 * r4 + 1] * inv); w.y = cvtpk(o[d][4 * r4 + 2] * inv, o[d][4 * r4 + 3] * inv);
            *(u32x2*)(orow + 32 * d + 8 * r4) = w;
        }
    if (hi == 0) ml[row * 8 + head] = (f32x2){m, l};
}

__device__ __forceinline__ void dil_stream(LAS unsigned char* lds, const bf16* proj, bf16* part_base, f32x2* ml_base, int u0, int ustep, int utotal) {
    constexpr int ND = 2, W = 128, VB = 8192, VOFF = 6 * KBUF;
    const int tid = ltid(), lane = tid & 63, r32 = lane & 31, hi = lane >> 5;
    const int wid = __builtin_amdgcn_readfirstlane(tid >> 6);
    const int krow = tid >> 3, kch = tid & 7;
    const int kwoff = krow * KROW + kch * 16;
    const int vrow0 = (tid >> 4) * 2 + ((tid >> 2) & 1), vch = ((tid >> 3) & 1) * 4 + (tid & 3);
    const int vwoff = (vch >> 2) * 4096 + (vrow0 >> 4) * 1024 + (vrow0 & 15) * 64 + (vch & 3) * 16;
    const int kroff = r32 * KROW + hi * 16;
    const int vroff = (4 * hi + ((lane & 15) >> 2)) * 64 + ((lane >> 4) & 1) * 32 + (lane & 3) * 8;
    u32x4 kst[6], vst[6]; bf16x8 qn[4];
    int u = u0; if (u >= utotal) return;
    int cb, chead, cdil, cres, clblk, cbr;
#define DS_DECODE(U_) do { cbr = (U_) >> 11; const int rem_ = (U_) & 2047, bhd_ = rem_ >> 5, blk_ = rem_ & 31; const int sh_ = (cbr == 0) ? 5 : (cbr == 1 ? 3 : 1); \
        cdil = (cbr == 0) ? 1 : (cbr == 1 ? 4 : 16); cb = bhd_ >> 3; chead = bhd_ & 7; cres = blk_ >> sh_; clblk = blk_ & ((1 << sh_) - 1); } while (0)
#define DS_LOAD() do { const int tl_ = (4 * clblk - 2) > 0 ? (4 * clblk - 2) : 0, nt_ = 4 * clblk + 4 - tl_; \
        const bf16* base_ = proj + ((size_t)cb * S + cres) * PW + chead * 64; const size_t rs_ = (size_t)cdil * PW; \
        _Pragma("unroll") for (int j = 0; j < 6; ++j) if (j < nt_) { \
            kst[j] = *(const u32x4*)(base_ + 2048 + (size_t)((tl_ + j) * 64 + krow) * rs_ + kch * 8); \
            vst[j] = *(const u32x4*)(base_ + 2560 + (size_t)((tl_ + j) * 64 + vrow0) * rs_ + vch * 8); } \
        const bf16* q_ = proj + ((size_t)cb * S + (size_t)(clblk * 256 + wid * 32 + r32) * cdil + cres) * PW + 1536 + chead * 64 + 8 * hi; \
        _Pragma("unroll") for (int d0 = 0; d0 < 4; ++d0) qn[d0] = *(const bf16x8*)(q_ + 16 * d0); } while (0)
    DS_DECODE(u);
    DS_LOAD();
    for (;;) {
        const int t_lo = (4 * clblk - 2) > 0 ? (4 * clblk - 2) : 0, ntu = 4 * clblk + 4 - t_lo;
#pragma unroll
        for (int j = 0; j < 6; ++j) if (j < ntu) { *(LAS u32x4*)(lds + j * KBUF + kwoff) = kst[j]; *(LAS u32x4*)(lds + VOFF + j * VB + vwoff) = vst[j]; }
        bf16x8 qf[4];
#pragma unroll
        for (int d0 = 0; d0 < 4; ++d0) qf[d0] = qn[d0];
        __syncthreads();
        const int wq_lo = clblk * 256 + wid * 32, ql = wq_lo + r32;
        const size_t row = (size_t)cb * S + (size_t)ql * cdil + cres;
        const int head = chead;
        bf16* part = part_base + (size_t)cbr * M * 512; f32x2* ml = ml_base + (size_t)cbr * M * 8;
        const int un = u + ustep; const bool has_next = un < utotal;
        if (has_next) { DS_DECODE(un); DS_LOAD(); }
        f32x16 o[2]; o[0] = (f32x16){}; o[1] = (f32x16){};
        float m = 0.f, l = 0.f;
        f32x16 negm = (f32x16){};
#pragma unroll 2
        for (int j = 0; j < ntu; ++j) {
            LAS unsigned char* kbuf = lds + j * KBUF;
            LAS unsigned char* vbuf = lds + VOFF + j * VB;
            const int t = t_lo + j;
            AT_TILE();
        }
        l = partner_sum(l);
        const float inv = 1.0f / l;
        bf16* orow = part + row * 512 + head * 64 + 4 * hi;
#pragma unroll
        for (int d = 0; d < 2; ++d)
#pragma unroll
            for (int r4 = 0; r4 < 4; ++r4) {
                u32x2 w; w.x = cvtpk(o[d][4 * r4] * inv, o[d][4 * r4 + 1] * inv); w.y = cvtpk(o[d][4 * r4 + 2] * inv, o[d][4 * r4 + 3] * inv);
                *(u32x2*)(orow + 32 * d + 8 * r4) = w;
            }
        if (hi == 0) ml[row * 8 + head] = (f32x2){m, l};
        __syncthreads();
        if (!has_next) break;
        u = un;
    }
#undef DS_DECODE
#undef DS_LOAD
}
#undef AT_TILE
}

constexpr size_t MiB = (size_t)1 << 20;
constexpr size_t WS_ROPE = 1 * MiB;
constexpr size_t WS_SSP = 3 * MiB;
constexpr size_t WS_W = 8 * MiB;
constexpr size_t W_GU1 = 0, W_D1 = 11 * MiB, W_GU2 = W_D1 + 5 * MiB + 512 * 1024, W_D2 = W_GU2 + 11 * MiB, W_IN = W_D2 + 5 * MiB + 512 * 1024, W_OUT = W_IN + 6 * MiB;
constexpr size_t WS_XB = 64 * MiB;
constexpr size_t WS_PROJ = 192 * MiB;
constexpr size_t WS_MRG = 576 * MiB;
constexpr size_t WS_PART = 704 * MiB;
constexpr size_t WS_ML = 896 * MiB;
constexpr size_t WS_STASH = 908 * MiB;
constexpr size_t WS_W1 = 940 * MiB;
constexpr size_t WS_END = 984 * MiB;
constexpr int LDS_BYTES = 147456;

#define XB_TMO      128
#define XB_XCNT(j)  (256  + 64 * (j))
#define XB_XSUB(j)  (1280 + 64 * (j))
#define XB_XGEN(j)  (2304 + 64 * (j))
#define XB_TOP      3328
#define XB_TOPGEN   3392
#define XCD_BAR_WORDS 3456
#define XB_SPIN_CAP (1u << 18)

__device__ __forceinline__ unsigned xb_ld(unsigned* p)              { return __hip_atomic_load(p, __ATOMIC_RELAXED, __HIP_MEMORY_SCOPE_AGENT); }
__device__ __forceinline__ unsigned xb_add(unsigned* p, unsigned v) { return __hip_atomic_fetch_add(p, v, __ATOMIC_RELAXED, __HIP_MEMORY_SCOPE_AGENT); }
__device__ __forceinline__ unsigned xb_xcc_id() { return (unsigned)__builtin_amdgcn_s_getreg((3 << 11) | 20) & 0xFu; }
#define XB_SPIN(cond, bar) do { unsigned _sp = 0; while (cond) { __builtin_amdgcn_s_sleep(1); \
    if ((++_sp & 255u) == 0u) { if (xb_ld(&(bar)[XB_TMO])) break; if (_sp > XB_SPIN_CAP) { atomicAdd(&(bar)[XB_TMO], 1u); break; } } } } while (0)

struct XcdBarrier {
    unsigned* bar; unsigned x;
    volatile LAS unsigned* st;
};

__device__ __forceinline__ XcdBarrier xcd_barrier_post(unsigned* bar, volatile LAS unsigned* st) {
    XcdBarrier b; b.bar = bar; b.x = xb_xcc_id(); b.st = st;
    if (threadIdx.x == 0) (void)xb_add(&bar[XB_XCNT(b.x)], 1u);
    return b;
}
__device__ __forceinline__ void xcd_barrier_complete(unsigned* bar, unsigned x, unsigned& nloc, unsigned& nx) {
    const unsigned G = gridDim.x * gridDim.y * gridDim.z;
    unsigned sum, cnt, mine, sp = 0u;
    for (;;) {
        sum = 0u; cnt = 0u; mine = 0u;
#pragma unroll
        for (unsigned j = 0; j < 16; ++j) { const unsigned c = xb_ld(&bar[XB_XCNT(j)]); sum += c; cnt += (c > 0u) ? 1u : 0u; mine = (j == x) ? c : mine; }
        if (sum == G) break;
        __builtin_amdgcn_s_sleep(1);
        if ((++sp & 255u) == 0u) { if (xb_ld(&bar[XB_TMO])) break; if (sp > XB_SPIN_CAP) { atomicAdd(&bar[XB_TMO], 1u); break; } }
    }
    nloc = mine > 0u ? mine : 1u; nx = cnt > 0u ? cnt : 1u;
}

__device__ __forceinline__ void xcd_barrier(const XcdBarrier& b) {
    asm volatile("s_waitcnt vmcnt(0)" ::: "memory");
    __syncthreads();
    if (threadIdx.x == 0) {
        unsigned* bar = b.bar;
        __builtin_amdgcn_s_waitcnt(0);
        unsigned nloc = b.st[0], nx = b.st[1];
        if (nloc == 0u) { xcd_barrier_complete(bar, b.x, nloc, nx); b.st[0] = nloc; b.st[1] = nx; }
        const unsigned old = xb_add(&bar[XB_XSUB(b.x)], 1u);
        const unsigned gen = old / nloc;
        if (old + 1u == (gen + 1u) * nloc) {
            __builtin_amdgcn_fence(__ATOMIC_RELEASE, "agent");
            asm volatile("s_waitcnt vmcnt(0)" ::: "memory");
            const unsigned og = xb_add(&bar[XB_TOP], 1u);
            const unsigned tg = og / nx;
            if (og + 1u == (tg + 1u) * nx) xb_add(&bar[XB_TOPGEN], 1u);
            else XB_SPIN(xb_ld(&bar[XB_TOPGEN]) == tg, bar);
            __builtin_amdgcn_fence(__ATOMIC_ACQUIRE, "agent");
            xb_add(&bar[XB_XGEN(b.x)], 1u);
            asm volatile("s_waitcnt vmcnt(0)" ::: "memory");
        } else {
            XB_SPIN(xb_ld(&bar[XB_XGEN(b.x)]) == gen, bar);
            __builtin_amdgcn_fence(__ATOMIC_ACQUIRE, "agent");
            asm volatile("s_waitcnt vmcnt(0)" ::: "memory");
        }
    }
    __syncthreads();
}

constexpr size_t WS_BAR = 0, BAR_ZERO_BYTES = 16384;
constexpr int LDS_MISC = 131072 + 512;
struct Args { const void* in[20]; float* out; unsigned char* ws; float lam_init[4]; int ph_lo, ph_hi; };

__device__ __forceinline__ float wave_sum(float v) {
#pragma unroll
    for (int o = 1; o < 64; o <<= 1) v += __shfl_xor(v, o);
    return v;
}
__device__ __forceinline__ unsigned f2bf(float f) { unsigned u = __builtin_bit_cast(unsigned, f); return (u + 0x7fffu + ((u >> 16) & 1u)) >> 16; }
__device__ __forceinline__ unsigned pk2(float lo, float hi) { return f2bf(lo) | (f2bf(hi) << 16); }
__device__ __forceinline__ float bf2f(unsigned short h) { return __builtin_bit_cast(float, (unsigned)h << 16); }

__device__ __forceinline__ void conv_item(const float* W, int K, int N, bf16* WT, int rmode, int part, int gmode, const float* g0, const float* g1, float gs, LAS float* scr, int item, int lane) {
    const int nblk = N / 32, kb = item / nblk, nb = item % nblk, k0 = 64 * kb, n0 = 32 * nb;
#pragma unroll 8
    for (int i = 0; i < 32; ++i) {
        const int kk = 2 * i + (lane >> 5), k = k0 + kk;
        float g = 1.0f;
        if (gmode == 1) g = g0[k]; else if (gmode == 2) g = (k < 512) ? g0[k & 127] * gs : g1[k - 512];
        scr[kk * 33 + (lane & 31)] = W[(size_t)k * N + n0 + (lane & 31)] * g;
    }
    asm volatile("s_waitcnt lgkmcnt(0)" ::: "memory");
    const int c = lane & 7;
#pragma unroll
    for (int j = 0; j < 4; ++j) {
        const int nl = (lane >> 3) + 8 * j, n = n0 + nl; const LAS float* s = scr + (8 * c) * 33 + nl;
        int rowd = n;
        if (rmode == 1) rowd = ((n >> 7) << 8) + part * 128 + (n & 127);
        else if (rmode == 2) { const int cc = n & 255; rowd = (n & ~255) + ((cc >> 5) & 1) * 128 + (cc >> 6) * 32 + (cc & 31); }
        u32x4 o; o.x = pk2(s[0 * 33], s[1 * 33]); o.y = pk2(s[2 * 33], s[3 * 33]); o.z = pk2(s[4 * 33], s[5 * 33]); o.w = pk2(s[6 * 33], s[7 * 33]);
        *(u32x4*)(WT + (size_t)rowd * K + k0 + 8 * c) = o;
    }
    asm volatile("s_waitcnt lgkmcnt(0)" ::: "memory");
}

typedef const Args __attribute__((address_space(4)))* ArgsP;
__device__ __forceinline__ void convert_layer(ArgsP ap, int l, LAS unsigned char* lds, int gw, int ngw, int wave, int lane) {
    LAS float* scr = (LAS float*)(lds + wave * 16384);
    unsigned char* wb = ap->ws + ((l & 1) ? WS_W1 : WS_W);
    constexpr int I_G = (D / 64) * (FF / 32), I_D = (FF / 64) * (D / 32), I_IN = (D / 64) * (PW / 32), I_OUT = (D / 64) * (D / 32);
    constexpr int NITEMS = 4 * I_G + 2 * I_D + I_IN + I_OUT;
    const size_t wgu = (size_t)D * FF;
    const float* n1 = (const float*)ap->in[2] + l * D; const float* n2 = (const float*)ap->in[15] + l * D; const float* nm = (const float*)ap->in[6] + l * D;
    for (int it = gw; it < NITEMS; it += ngw) {
        int r = it;
        if (r < I_G) { conv_item((const float*)ap->in[3] + l * wgu, D, FF, (bf16*)(wb + W_GU1), 1, 0, 1, n1, nullptr, 1.f, scr, r, lane); continue; } r -= I_G;
        if (r < I_G) { conv_item((const float*)ap->in[4] + l * wgu, D, FF, (bf16*)(wb + W_GU1), 1, 1, 1, n1, nullptr, 1.f, scr, r, lane); continue; } r -= I_G;
        if (r < I_D) { conv_item((const float*)ap->in[5] + l * wgu, FF, D, (bf16*)(wb + W_D1), 0, 0, 0, nullptr, nullptr, 1.f, scr, r, lane); continue; } r -= I_D;
        if (r < I_G) { conv_item((const float*)ap->in[16] + l * wgu, D, FF, (bf16*)(wb + W_GU2), 1, 0, 1, n2, nullptr, 1.f, scr, r, lane); continue; } r -= I_G;
        if (r < I_G) { conv_item((const float*)ap->in[17] + l * wgu, D, FF, (bf16*)(wb + W_GU2), 1, 1, 1, n2, nullptr, 1.f, scr, r, lane); continue; } r -= I_G;
        if (r < I_D) { conv_item((const float*)ap->in[18] + l * wgu, FF, D, (bf16*)(wb + W_D2), 0, 0, 0, nullptr, nullptr, 1.f, scr, r, lane); continue; } r -= I_D;
        if (r < I_IN) { conv_item((const float*)ap->in[7] + (size_t)l * D * PW, D, PW, (bf16*)(wb + W_IN), 2, 0, 1, nm, nullptr, 1.f, scr, r, lane); continue; } r -= I_IN;
        conv_item((const float*)ap->in[14] + (size_t)l * D * D, D, D, (bf16*)(wb + W_OUT), 0, 0, 2, (const float*)ap->in[12] + l * 128, (const float*)ap->in[13] + l * 512, 1.0f - ap->lam_init[l], scr, r, lane);
    }
}

__global__ void __launch_bounds__(NTHR, 2) mega(Args a) {
    extern __shared__ __attribute__((aligned(16))) unsigned char lds_raw[];
    LAS unsigned char* lds = (LAS unsigned char*)lds_raw;
    const int ph_lo = a.ph_lo, ph_hi = a.ph_hi;
    volatile LAS unsigned* bst = (volatile LAS unsigned*)(lds + LDS_MISC);
    if (threadIdx.x < 2) bst[threadIdx.x] = 0u;
    __syncthreads();
    XcdBarrier bar; bar.bar = (unsigned*)(a.ws + WS_BAR); bar.x = 0; bar.st = bst;
    if (ph_hi - ph_lo > 1) bar = xcd_barrier_post((unsigned*)(a.ws + WS_BAR), bst);
    for (int ph = ph_lo; ph < ph_hi; ++ph) {
        const int tid = ltid(), lane = tid & 63, wave = __builtin_amdgcn_readfirstlane(tid >> 6);
        int G = gridDim.x, bx = blockIdx.x; asm volatile("" : "+s"(G), "+s"(bx));
        const int vcu = (G % 8 == 0) ? (bx % 8) * (G / 8) + bx / 8 : bx;
        const int gw = vcu * NWAVES + wave, ngw = G * NWAVES;
        ArgsP ap = (ArgsP)__builtin_amdgcn_kernarg_segment_ptr();
        asm volatile("" : "+s"(ap));
        unsigned char* ws = ap->ws;
        float* X = ap->out;
        bf16* XB = (bf16*)(ws + WS_XB);
        float* ssp = (float*)(ws + WS_SSP);
        float* cs = (float*)(ws + WS_ROPE);
        bf16* PROJ = (bf16*)(ws + WS_PROJ);
        bf16* HB = (bf16*)(ws + WS_PROJ);
        bf16* MRG = (bf16*)(ws + WS_MRG);
        if (ph == 0) {
            const float* xin = (const float*)ap->in[0];
            for (int row = gw; row < M; row += ngw) {
                const f32x4* xr = (const f32x4*)(xin + (size_t)row * D) + lane;
                u32x2* xb = (u32x2*)(XB + (size_t)row * D) + lane;
                float s = 0.f;
#pragma unroll
                for (int j = 0; j < 4; ++j) {
                    const f32x4 v = xr[64 * j]; s += (v[0] * v[0] + v[1] * v[1]) + (v[2] * v[2] + v[3] * v[3]);
                    u32x2 w; w.x = pk2(v[0], v[1]); w.y = pk2(v[2], v[3]); xb[64 * j] = w;
                }
                s = wave_sum(s);
                if (lane < 16) ssp[(size_t)row * 16 + lane] = (lane == 0) ? s : 0.f;
            }
            const int* pos = (const int*)ap->in[1];
            for (int idx = bx * NTHR + tid; idx < S * 32; idx += G * NTHR) {
                const int s_ = idx >> 5, j = idx & 31;
                double inv = 1.0; for (int q = 0; q < j; ++q) inv *= 0.7498942093324559;
                const float invf = (float)inv;
                const float angf = (float)pos[s_] * invf;
                const double ang = (double)angf;
                const double kk = __builtin_rint(ang * 0.15915494309189535);
                const double r = ang - kk * 6.283185307179586;
                const double x2 = r * r;
                double c = 1.0, sn = r, tc = 1.0, ts = r;
#pragma unroll
                for (int k = 1; k <= 14; ++k) { tc *= -x2 / (double)((2 * k - 1) * (2 * k)); c += tc; ts *= -x2 / (double)((2 * k) * (2 * k + 1)); sn += ts; }
                cs[(size_t)s_ * 64 + j] = (float)c; cs[(size_t)s_ * 64 + 32 + j] = (float)sn;
            }
            convert_layer(ap, 0, lds, gw, ngw, wave, lane);
        } else if (ph == 1 + 8 * DEPTH) {
            const float* g = (const float*)ap->in[19];
            for (int row = gw; row < M; row += ngw) {
                const u32x2* xb = (const u32x2*)(XB + (size_t)row * D) + lane;
                f32x4* xo = (f32x4*)(X + (size_t)row * D) + lane;
                f32x4 v[4]; float s = 0.f;
#pragma unroll
                for (int j = 0; j < 4; ++j) { const u32x2 w = xb[64 * j];
                    v[j] = (f32x4){__builtin_bit_cast(float, w.x << 16), __builtin_bit_cast(float, w.x & 0xffff0000u), __builtin_bit_cast(float, w.y << 16), __builtin_bit_cast(float, w.y & 0xffff0000u)};
                    s += (v[j][0] * v[j][0] + v[j][1] * v[j][1]) + (v[j][2] * v[j][2] + v[j][3] * v[j][3]); }
                const float rs = 1.0f / sqrtf(wave_sum(s) * (1.0f / D) + 1e-6f);
#pragma unroll
                for (int j = 0; j < 4; ++j) { const f32x4 gg = ((const f32x4*)g)[lane + 64 * j]; xo[64 * j] = v[j] * rs * gg; }
            }
        } else {
            const int l = (ph - 1) / 8, k = (ph - 1) % 8;
            unsigned char* wb = ws + ((l & 1) ? WS_W1 : WS_W);
            if (k == 0 || k == 6) {
                pg8::Gemm g{XB, (const bf16*)(wb + (k == 0 ? W_GU1 : W_GU2)), M, 2 * FF, D};
                pg8::StaticOrder SO; SO.init(M, 2 * FF, G, bx);
                pg8::EpiGU E{HB, ssp, FF};
#ifndef SK_GU
                for (int rep_ = 0; rep_ < REP_GU; ++rep_)
                pg8::gemm_phase<pg8::EpiGU, pg8::StaticOrder, true, true>(lds, g, SO, E);
#endif
            } else if (k == 1 || k == 7 || k == 5) {
                pg8::Gemm g{k == 5 ? MRG : HB, (const bf16*)(wb + (k == 1 ? W_D1 : (k == 7 ? W_D2 : W_OUT))), M, D, k == 5 ? D : FF};
                pg8::StaticOrder SO; SO.init(M, D, G, bx);
#ifndef SK_RES
                for (int rep_ = 0; rep_ < REP_RES; ++rep_) {
                pg8::EpiRes E{XB, ssp, rep_ + 1 < REP_RES ? 0.0f : (k == 5 ? 1.0f : 0.5f)};
                pg8::gemm_phase<pg8::EpiRes, pg8::StaticOrder, true, true>(lds, g, SO, E);
                }
#endif
            } else if (k == 2) {
                pg8::Gemm g{XB, (const bf16*)(wb + W_IN), M, PW, D};
                pg8::StaticOrder SO; SO.init(M, PW, G, bx);
                pg8::EpiProj E{PROJ, ssp, cs};
#ifndef SK_PROJ
                for (int rep_ = 0; rep_ < REP_PROJ; ++rep_)
                pg8::gemm_phase<pg8::EpiProj, pg8::StaticOrder, true, true>(lds, g, SO, E);
#endif
            } else if (k == 3) {
                float s1 = ((const float*)ap->in[8])[l * 64 + lane] * ((const float*)ap->in[9])[l * 64 + lane];
                float s2 = ((const float*)ap->in[10])[l * 64 + lane] * ((const float*)ap->in[11])[l * 64 + lane];
                s1 = wave_sum(s1); s2 = wave_sum(s2);
                const float lam = expf(s1) - expf(s2) + ap->lam_init[l];
                float* stash = (float*)(ws + WS_STASH);
              for (int rep_ = 0; rep_ < REP_DIFF; ++rep_)
                for (int r = 0; r < 4; ++r) {
                    const int per = G >> 3, xcd = vcu / per, i = vcu % per;
                    const int bh = (xcd * 4 + r) & 31, qb = ((r & 1) ? 31 - i : i) & 31;
#ifndef SK_DIFF
                    if (per == 32 && (G & 7) == 0) at::diff_unit(lds, PROJ, MRG, stash, lam, bh >> 2, bh & 3, qb, bx);
#endif
                }
              if ((G >> 3) != 32 || (G & 7))
                for (int pi = vcu; pi < 512; pi += G)
#pragma unroll 1
                    for (int i = 0; i < 2; ++i) { const int bh = pi >> 4, s_ = pi & 15, qb = i ? 31 - s_ : s_; at::diff_unit(lds, PROJ, MRG, stash, lam, bh >> 2, bh & 3, qb, bx); }
              for (int rep_ = 0; rep_ < REP_DIL; ++rep_)
                at::dil_stream(lds, PROJ, (bf16*)(ws + WS_PART), (f32x2*)(ws + WS_ML), vcu, G, 6144);
                for (int rep_ = 0; rep_ < REP_MISC; ++rep_)
                if (l + 1 < DEPTH) convert_layer(ap, l + 1, lds, gw, ngw, wave, lane);
            } else if (k == 4) {
                const bf16* part = (const bf16*)(ws + WS_PART); const f32x2* ml = (const f32x2*)(ws + WS_ML);
                for (int rep_ = 0; rep_ < REP_MISC; ++rep_)
                for (int row = gw; row < M; row += ngw) {
                    u32x4 pv[3]; f32x2 mv[3];
#pragma unroll
                    for (int b = 0; b < 3; ++b) { pv[b] = *(const u32x4*)(part + ((size_t)b * M + row) * 512 + 8 * lane); mv[b] = ml[((size_t)b * M + row) * 8 + (lane >> 3)]; }
                    const float mall = fmaxf(mv[0].x, fmaxf(mv[1].x, mv[2].x));
                    float w[3], wsum = 0.f;
#pragma unroll
                    for (int b = 0; b < 3; ++b) { w[b] = mv[b].y * __builtin_amdgcn_exp2f(mv[b].x - mall); wsum += w[b]; }
                    const float iw = 1.0f / wsum;
                    float o[8]; float ss = 0.f;
#pragma unroll
                    for (int i = 0; i < 8; ++i) {
                        float acc = 0.f;
#pragma unroll
                        for (int b = 0; b < 3; ++b) { const unsigned wd = pv[b][i >> 1]; acc += w[b] * bf2f((unsigned short)((i & 1) ? (wd >> 16) : (wd & 0xffffu))); }
                        o[i] = acc * iw; ss += o[i] * o[i];
                    }
                    const float rs = __builtin_amdgcn_rsqf(wave_sum(ss) * (1.0f / 512.0f) + 1e-6f);
                    u32x4 wv; wv.x = pk2(o[0] * rs, o[1] * rs); wv.y = pk2(o[2] * rs, o[3] * rs); wv.z = pk2(o[4] * rs, o[5] * rs); wv.w = pk2(o[6] * rs, o[7] * rs);
                    *(u32x4*)(MRG + (size_t)row * D + 512 + 8 * lane) = wv;
                }
            }
        }
        if (ph + 1 < ph_hi) {
            for (int rep_ = 0; rep_ < REP_SYNC; ++rep_) { if (ph == ph_lo) cg::this_grid().sync(); else xcd_barrier(bar); }
        }
    }
}

extern "C" void kernel_launch(void* const* d_in, const int* in_sizes, int n_in, void* d_out, int out_size, void* d_ws, size_t ws_size, hipStream_t stream) {
    static int grid = 0;
    if (grid == 0) {
        if (n_in != 20 || out_size != M * D || ws_size < WS_END) { fprintf(stderr, "kernel_launch: unexpected problem (n_in %d, out %d, ws %zu)\n", n_in, out_size, ws_size); grid = -1; return; }
        int dev = 0, cus = 0, per_cu = 0;
        hipGetDevice(&dev);
        hipDeviceGetAttribute(&cus, hipDeviceAttributeMultiprocessorCount, dev);
        if (hipFuncSetAttribute((const void*)mega, hipFuncAttributeMaxDynamicSharedMemorySize, LDS_BYTES) != hipSuccess) { fprintf(stderr, "kernel_launch: hipFuncSetAttribute failed\n"); grid = -1; return; }
        if (hipOccupancyMaxActiveBlocksPerMultiprocessor(&per_cu, (const void*)mega, NTHR, LDS_BYTES) != hipSuccess || per_cu < 1) { fprintf(stderr, "kernel_launch: occupancy query says %d\n", per_cu); per_cu = 1; (void)hipGetLastError(); }
        grid = cus * per_cu;
    }
    if (grid < 0) return;
    Args a{};
    for (int i = 0; i < 20; ++i) a.in[i] = d_in[i];
    a.out = (float*)d_out; a.ws = (unsigned char*)d_ws;
    a.lam_init[0] = 0.2f; a.lam_init[1] = (float)(0.8 - 0.6 * 0.7408182206817179); a.lam_init[2] = (float)(0.8 - 0.6 * 0.5488116360940264); a.lam_init[3] = (float)(0.8 - 0.6 * 0.4065696597405991);
    constexpr int NPH = 2 + 8 * DEPTH;
#if MK_PER_PHASE
    for (int ph = 0; ph < NPH; ++ph) {
        a.ph_lo = ph; a.ph_hi = ph + 1;
        hipLaunchKernelGGL(mega, dim3(grid), dim3(NTHR), LDS_BYTES, stream, a);
    }
#else
    a.ph_lo = 0; a.ph_hi = NPH;
    if (hipMemsetAsync((char*)d_ws + WS_BAR, 0, BAR_ZERO_BYTES, stream) != hipSuccess) { fprintf(stderr, "kernel_launch: hipMemsetAsync failed\n"); return; }
    void* args[] = {&a};
    hipError_t e = hipLaunchCooperativeKernel((const void*)mega, dim3(grid), dim3(NTHR), args, LDS_BYTES, stream);
    if (e != hipSuccess) fprintf(stderr, "kernel_launch: cooperative launch failed: %s (grid %d)\n", hipGetErrorString(e), grid);
#endif
}
```

```cpp
#include <hip/hip_runtime.h>
#include <hip/hip_cooperative_groups.h>
#include <cstdio>
#include <cstdint>
namespace cg = cooperative_groups;
#ifndef MK_PER_PHASE
#define MK_PER_PHASE 0
#endif
#ifndef REP_DIFF
#define REP_DIFF 1
#endif
#ifndef REP_DIL
#define REP_DIL 1
#endif
#ifndef REP_GU
#define REP_GU 1
#endif
#ifndef REP_PROJ
#define REP_PROJ 1
#endif
#ifndef REP_RES
#define REP_RES 1
#endif
#ifndef REP_MISC
#define REP_MISC 1
#endif
#ifndef REP_SYNC
#define REP_SYNC 1
#endif
namespace pg8 {
#define PG8_LAS __attribute__((address_space(3)))
typedef unsigned short bf16_t;
typedef short bf16x8 __attribute__((ext_vector_type(8)));
typedef float f32x4 __attribute__((ext_vector_type(4)));
typedef unsigned u32x4 __attribute__((ext_vector_type(4)));
constexpr int BM = 256, BK = 64, HALF = 128, HTB = HALF * BK * 2  , STAGE_BYTES = 8 * HTB, NXCD = 8, WGM = 4;

__host__ __device__ __forceinline__ int lds_byte(int r, int c) { const int st = (r >> 4) * 2 + (c >> 5), rr = r & 15, cc = c & 31, ob = rr * 64 + cc * 2; return st * 1024 + (ob ^ (((ob >> 9) & 1) << 5)); }
__host__ __device__ __forceinline__ void stage_rc(int b, int& R, int& C) { const int st = b / 1024, sb = b % 1024, swz = sb ^ (((sb >> 9) & 1) << 5); R = (st >> 1) * 16 + swz / 64; C = (st & 1) * 32 + (swz % 64) / 2; }
__host__ __device__ __forceinline__ int perm32(int rho) { const int n = rho >> 4, i = rho & 15; return 8 * (i >> 2) + 4 * n + (i & 3); }

struct Unit { int pm, pn; };
struct Gemm { const bf16_t* A; const bf16_t* Bt; int M, N, K; };

struct StaticOrder {
    int nM, nN, nwg, G, c;
    __host__ __device__ void init(int M, int N, int G_, int c_) { nM = M / BM; nN = N / BM; nwg = nM * nN; G = G_; c = c_; }
    __host__ __device__ bool next(int i, Unit& u) const {
        const long L = (long)i * G + c; if (L >= nwg) return false;
        int wgid = (int)L; { const int q = nwg / NXCD, r = nwg % NXCD, xcd = wgid % NXCD, off = wgid / NXCD; wgid = (xcd < r ? xcd * (q + 1) : r * (q + 1) + (xcd - r) * q) + off; }
        const int nig = WGM * nN, gid = wgid / nig, fm = gid * WGM, gsz = (nM - fm) < WGM ? (nM - fm) : WGM;
        u.pm = fm + ((wgid % nig) % gsz); u.pn = (wgid % nig) / gsz; return true;
    }
    __device__ __forceinline__ void a_ready(const Unit&) const {}
    __device__ __forceinline__ void done(const Unit&) const {}
};
__device__ __forceinline__ unsigned cvt_pk_bf16(float lo, float hi) { unsigned r; asm volatile("v_cvt_pk_bf16_f32 %0, %1, %2" : "=v"(r) : "v"(lo), "v"(hi)); return r; }
typedef float f32x2 __attribute__((ext_vector_type(2)));
typedef unsigned u32x2 __attribute__((ext_vector_type(2)));
constexpr int NSSP = 16;
__device__ __forceinline__ void rows_rstd(float (&rs)[8], const float* ssp, int row0, int fq, float mul) {
    f32x4 v[8];
#pragma unroll
    for (int j = 0; j < 8; ++j) v[j] = ((const f32x4*)(ssp + (size_t)(row0 + (j >> 2) * HALF + (j & 3) * 16) * NSSP))[fq];
#pragma unroll
    for (int j = 0; j < 8; ++j) {
        float t = (v[j][0] + v[j][1]) + (v[j][2] + v[j][3]);
        t += __shfl_xor(t, 16); t += __shfl_xor(t, 32);
        rs[j] = mul * __builtin_amdgcn_rsqf(t * (1.0f / 1024.0f) + 1e-6f);
    }
}
struct EpiGU {
    static constexpr bool PERM = true, AFTER_DRAIN = false;
    bf16_t* H; const float* ssp; int ldh;
    __device__ __forceinline__ void operator()(const f32x4 (&acc)[2][2][4][2], const Unit& u, int wr, int wc, int fr_, int fq_) const {
        int fr = fr_, fq = fq_; asm volatile("" : "+v"(fr), "+v"(fq));
        const int row0 = u.pm * BM + wr * 64 + fr, col0 = u.pn * HALF + wc * 32 + 8 * fq;
        float rsv[8]; rows_rstd(rsv, ssp, row0, fq, 1.0f);
#pragma unroll
        for (int ai = 0; ai < 2; ++ai)
#pragma unroll
            for (int m = 0; m < 4; ++m) {
                const int row = row0 + ai * HALF + m * 16;
                const float rs = rsv[ai * 4 + m], rsn = -1.4426950408889634f * rs, rs2 = rs * rs;
                f32x2 t[4], ab[4];
#pragma unroll
                for (int q = 0; q < 4; ++q) {
                    const f32x2 a2 = (f32x2){acc[ai][0][m][q >> 1][(2 * q) & 3], acc[ai][0][m][q >> 1][(2 * q + 1) & 3]};
                    const f32x2 b2 = (f32x2){acc[ai][1][m][q >> 1][(2 * q) & 3], acc[ai][1][m][q >> 1][(2 * q + 1) & 3]};
                    t[q] = a2 * rsn; ab[q] = (a2 * b2) * rs2;
                }
#pragma unroll
                for (int q = 0; q < 4; ++q) { t[q].x = __builtin_amdgcn_exp2f(t[q].x); t[q].y = __builtin_amdgcn_exp2f(t[q].y); }
#pragma unroll
                for (int q = 0; q < 4; ++q) t[q] = t[q] + 1.0f;
#pragma unroll
                for (int q = 0; q < 4; ++q) { t[q].x = __builtin_amdgcn_rcpf(t[q].x); t[q].y = __builtin_amdgcn_rcpf(t[q].y); }
#pragma unroll
                for (int q = 0; q < 4; ++q) ab[q] = ab[q] * t[q];
                u32x4 w; w.x = cvt_pk_bf16(ab[0].x, ab[0].y); w.y = cvt_pk_bf16(ab[1].x, ab[1].y); w.z = cvt_pk_bf16(ab[2].x, ab[2].y); w.w = cvt_pk_bf16(ab[3].x, ab[3].y);
                __builtin_nontemporal_store(w, (u32x4*)(H + (size_t)row * ldh + col0));
            }
    }
};
struct EpiRes {
    static constexpr bool PERM = true, AFTER_DRAIN = false;
    bf16_t* XB; float* ssp; float scale;
    __device__ __forceinline__ void operator()(const f32x4 (&acc)[2][2][4][2], const Unit& u, int wr, int wc, int fr_, int fq_) const {
        int fr = fr_, fq = fq_; asm volatile("" : "+v"(fr), "+v"(fq));
        const int row0 = u.pm * BM + wr * 64 + fr, col0 = u.pn * BM + wc * 32 + 8 * fq;
#pragma unroll
        for (int ai = 0; ai < 2; ++ai) {
            u32x4 xv[4][2];
#pragma unroll
            for (int m = 0; m < 4; ++m)
#pragma unroll
                for (int bj = 0; bj < 2; ++bj) xv[m][bj] = *(const u32x4*)(XB + (size_t)(row0 + ai * HALF + m * 16) * 1024 + col0 + bj * HALF);
#pragma unroll
            for (int m = 0; m < 4; ++m) {
                const int row = row0 + ai * HALF + m * 16;
                float ss = 0.f;
#pragma unroll
                for (int bj = 0; bj < 2; ++bj) {
                    float o[8];
#pragma unroll
                    for (int q = 0; q < 4; ++q) {
                        const unsigned wd = xv[m][bj][q];
                        const float x0 = __builtin_bit_cast(float, wd << 16), x1 = __builtin_bit_cast(float, wd & 0xffff0000u);
                        o[2 * q] = x0 + acc[ai][bj][m][q >> 1][(2 * q) & 3] * scale;
                        o[2 * q + 1] = x1 + acc[ai][bj][m][q >> 1][(2 * q + 1) & 3] * scale;
                    }
#pragma unroll
                    for (int q = 0; q < 8; ++q) ss += o[q] * o[q];
                    u32x4 w; w.x = cvt_pk_bf16(o[0], o[1]); w.y = cvt_pk_bf16(o[2], o[3]); w.z = cvt_pk_bf16(o[4], o[5]); w.w = cvt_pk_bf16(o[6], o[7]);
                    *(u32x4*)(XB + (size_t)row * 1024 + col0 + bj * HALF) = w;
                }
                ss += __shfl_xor(ss, 16); ss += __shfl_xor(ss, 32);
                if (fq == 0) ssp[(size_t)row * NSSP + u.pn * 4 + wc] = ss;
            }
            asm volatile("" ::: "memory");
        }
    }
};
struct EpiProj {
    static constexpr bool PERM = true, AFTER_DRAIN = false;
    bf16_t* P; const float* ssp; const float* cs;
    __device__ __forceinline__ void operator()(const f32x4 (&acc)[2][2][4][2], const Unit& u, int wr, int wc, int fr_, int fq_) const {
        int fr = fr_, fq = fq_; asm volatile("" : "+v"(fr), "+v"(fq));
        const int row0 = u.pm * BM + wr * 64 + fr;
        const int t = u.pn;
        const bool rope = !(t == 4 || t == 5 || t == 10 || t == 11);
        const float qs = (t < 2 || t == 6 || t == 7) ? 0.125f * 1.4426950408889634f : 1.0f;
        const int colL = t * BM + wc * 64 + 8 * fq;
        float rsv[8]; rows_rstd(rsv, ssp, row0, fq, qs);
#pragma unroll
        for (int hb = 0; hb < 4; ++hb) {
            const int ai = hb >> 1;
            f32x4 cv[2][4];
            if (rope) {
#pragma unroll
                for (int mm = 0; mm < 2; ++mm) {
                    const int m = (hb & 1) * 2 + mm;
                    const float* cp = cs + (size_t)((row0 + ai * HALF + m * 16) & 8191) * 64 + 8 * fq;
                    cv[mm][0] = *(const f32x4*)(cp); cv[mm][1] = *(const f32x4*)(cp + 4); cv[mm][2] = *(const f32x4*)(cp + 32); cv[mm][3] = *(const f32x4*)(cp + 36);
                }
            }
#pragma unroll
            for (int mm = 0; mm < 2; ++mm) {
                const int m = (hb & 1) * 2 + mm;
                const int row = row0 + ai * HALF + m * 16;
                const float rs = rsv[ai * 4 + m];
                float o1[8], o2[8];
                if (rope) {
                    const f32x4 c0 = cv[mm][0], c1 = cv[mm][1], s0 = cv[mm][2], s1 = cv[mm][3];
#pragma unroll
                    for (int i = 0; i < 4; ++i) {
                        const float a0 = acc[ai][0][m][0][i] * rs, b0 = acc[ai][1][m][0][i] * rs, a1 = acc[ai][0][m][1][i] * rs, b1 = acc[ai][1][m][1][i] * rs;
                        o1[i] = a0 * c0[i] - b0 * s0[i]; o2[i] = a0 * s0[i] + b0 * c0[i];
                        o1[4 + i] = a1 * c1[i] - b1 * s1[i]; o2[4 + i] = a1 * s1[i] + b1 * c1[i];
                    }
                } else {
#pragma unroll
                    for (int i = 0; i < 4; ++i) { o1[i] = acc[ai][0][m][0][i] * rs; o1[4 + i] = acc[ai][0][m][1][i] * rs; o2[i] = acc[ai][1][m][0][i] * rs; o2[4 + i] = acc[ai][1][m][1][i] * rs; }
                }
                u32x4 w1, w2;
                w1.x = cvt_pk_bf16(o1[0], o1[1]); w1.y = cvt_pk_bf16(o1[2], o1[3]); w1.z = cvt_pk_bf16(o1[4], o1[5]); w1.w = cvt_pk_bf16(o1[6], o1[7]);
                w2.x = cvt_pk_bf16(o2[0], o2[1]); w2.y = cvt_pk_bf16(o2[2], o2[3]); w2.z = cvt_pk_bf16(o2[4], o2[5]); w2.w = cvt_pk_bf16(o2[6], o2[7]);
                bf16_t* pr = P + (size_t)row * 3072 + colL;
                __builtin_nontemporal_store(w1, (u32x4*)(pr)); __builtin_nontemporal_store(w2, (u32x4*)(pr + 32));
            }
            asm volatile("" ::: "memory");
        }
    }
};
template <class Epi, class Sched, bool ALIGN_EPI = false, bool SP2 = false>
__device__ __forceinline__ void gemm_phase(PG8_LAS unsigned char* lds, const Gemm g, const Sched& S, const Epi& E) {
    int tid_ = threadIdx.x; asm volatile("" : "+v"(tid_));
    const int tid = tid_, wid = __builtin_amdgcn_readfirstlane(tid >> 6), lane = tid & 63, wr = wid >> 2, wc = wid & 3, fr = lane & 15, fq = lane >> 4;
    const int K = g.K, nt = K / BK;
    unsigned voffA[2], voffB[2];
#pragma unroll
    for (int i = 0; i < 2; ++i) { int R, C; stage_rc(tid * 16 + i * 8192, R, C); const int Rb = Epi::PERM ? ((R & ~31) + perm32(R & 31)) : R;
        voffA[i] = (unsigned)(R * K + C) * 2u; voffB[i] = (unsigned)(Rb * K + C) * 2u; }
    const size_t kstep = (size_t)(BK * 2);
    const size_t hstep = (size_t)HALF * K * 2;
    const size_t tstep = 2 * hstep;
    const unsigned ldsw = (unsigned)wid * 1024u;
    const int aoff = lds_byte(wr * 64 + fr, fq * 8), boff = lds_byte(wc * 32 + fr, fq * 8);
#define PG8_SA(b, h) (((b) * 2 + (h)) * HTB)
#define PG8_SB(b, h) ((4 + (b) * 2 + (h)) * HTB)
#define PG8_STAGE(bufoff, gbase, voff) do { _Pragma("unroll") for (int _i = 0; _i < 2; ++_i) \
        __builtin_amdgcn_global_load_lds((const unsigned*)((const char*)(gbase) + (voff)[_i]), (PG8_LAS unsigned*)(lds + (bufoff) + ldsw + _i * 8192), 16, 0, 0); } while (0)
#define PG8_LDA(dst, b, h) do { _Pragma("unroll") for (int m = 0; m < 4; ++m) _Pragma("unroll") for (int k = 0; k < 2; ++k) dst[m][k] = *(const PG8_LAS bf16x8*)(lds + PG8_SA(b, h) + aoff + m * 2048 + k * 1024); } while (0)
#define PG8_LDB(dst, b, h) do { _Pragma("unroll") for (int n = 0; n < 2; ++n) _Pragma("unroll") for (int k = 0; k < 2; ++k) dst[n][k] = *(const PG8_LAS bf16x8*)(lds + PG8_SB(b, h) + boff + n * 2048 + k * 1024); } while (0)
#define PG8_MMA(ai, bj, At, Bt) do { __builtin_amdgcn_s_setprio(1); _Pragma("unroll") for (int m = 0; m < 4; ++m) _Pragma("unroll") for (int n = 0; n < 2; ++n) _Pragma("unroll") for (int k = 0; k < 2; ++k) \
        acc[ai][bj][m][n] = __builtin_amdgcn_mfma_f32_16x16x32_bf16(Bt[n][k], At[m][k], acc[ai][bj][m][n], 0, 0, 0); __builtin_amdgcn_s_setprio(0); } while (0)
#define PG8_WAIT_V(n) asm volatile("s_waitcnt vmcnt(" #n ")" ::: "memory")
#define PG8_WAIT_L(n) asm volatile("s_waitcnt lgkmcnt(" #n ")" ::: "memory")
#define PG8_BAR __builtin_amdgcn_s_barrier()
#define PG8_SCHED __builtin_amdgcn_sched_barrier(0)
    Unit cur, nxt; int ui = 0;
    if (!S.next(0, cur)) return;
    f32x4 acc[2][2][4][2];
#pragma unroll
    for (int a = 0; a < 2; ++a)
#pragma unroll
        for (int b = 0; b < 2; ++b)
#pragma unroll
            for (int m = 0; m < 4; ++m)
#pragma unroll
                for (int n = 0; n < 2; ++n) acc[a][b][m][n] = (f32x4){0.f, 0.f, 0.f, 0.f};
    bf16x8 At[4][2], B0[2][2], B1[2][2];
    const char* cA = (const char*)g.A + (size_t)cur.pm * tstep; const char* cB = (const char*)g.Bt + (size_t)cur.pn * tstep;
    S.a_ready(cur);
    if constexpr (SP2) {
        PG8_STAGE(PG8_SB(0, 0), cB, voffB); PG8_STAGE(PG8_SB(0, 1), cB + hstep, voffB); PG8_STAGE(PG8_SA(0, 0), cA, voffA); PG8_STAGE(PG8_SA(0, 1), cA + hstep, voffA);
        if (wr == 1) PG8_BAR;
        PG8_WAIT_V(2); PG8_BAR;
        PG8_STAGE(PG8_SB(1, 0), cB + kstep, voffB); PG8_STAGE(PG8_SA(1, 0), cA + kstep, voffA); PG8_STAGE(PG8_SB(1, 1), cB + hstep + kstep, voffB);
        PG8_WAIT_V(6); PG8_BAR;
    } else {
        PG8_STAGE(PG8_SB(0, 0), cB, voffB); PG8_STAGE(PG8_SA(0, 0), cA, voffA); PG8_STAGE(PG8_SB(0, 1), cB + hstep, voffB); PG8_STAGE(PG8_SA(0, 1), cA + hstep, voffA);
        if (wr == 1) PG8_BAR;
        PG8_WAIT_V(4); PG8_BAR;
        PG8_STAGE(PG8_SB(1, 0), cB + kstep, voffB); PG8_STAGE(PG8_SA(1, 0), cA + kstep, voffA); PG8_STAGE(PG8_SB(1, 1), cB + hstep + kstep, voffB);
        PG8_WAIT_V(6); PG8_BAR;
    }
    for (;;) {
        const bool has_next = S.next(ui + 1, nxt);
        const char* nA = has_next ? (const char*)g.A + (size_t)nxt.pm * tstep : cA; const char* nB = has_next ? (const char*)g.Bt + (size_t)nxt.pn * tstep : cB;
        for (int t = 0; t < nt; t += 2) {
            const bool last = (t == nt - 2);
            const char* a1 = cA + (size_t)(t + 1) * kstep;
            const char* a2 = last ? nA : cA + (size_t)(t + 2) * kstep; const char* b2 = last ? nB : cB + (size_t)(t + 2) * kstep;
            const char* a3 = a2 + kstep; const char* b3 = b2 + kstep;
            if (last && has_next) S.a_ready(nxt);
            if constexpr (SP2) {
            PG8_LDB(B0, 0, 0); PG8_LDB(B1, 0, 1); PG8_SCHED; PG8_LDA(At, 0, 0); PG8_STAGE(PG8_SA(1, 1), a1 + hstep, voffA);
            PG8_WAIT_V(8); PG8_WAIT_L(0); PG8_BAR; PG8_MMA(0, 0, At, B0); PG8_MMA(0, 1, At, B1); PG8_BAR; PG8_SCHED;
            PG8_LDA(At, 0, 1); PG8_STAGE(PG8_SB(0, 0), b2, voffB); PG8_STAGE(PG8_SB(0, 1), b2 + hstep, voffB); PG8_STAGE(PG8_SA(0, 0), a2, voffA);
            PG8_WAIT_V(8); PG8_WAIT_L(0); PG8_BAR; PG8_MMA(1, 0, At, B0); PG8_MMA(1, 1, At, B1); PG8_BAR; PG8_SCHED;
            PG8_LDB(B0, 1, 0); PG8_LDB(B1, 1, 1); PG8_SCHED; PG8_LDA(At, 1, 0); PG8_STAGE(PG8_SA(0, 1), a2 + hstep, voffA);
            PG8_WAIT_V(8); PG8_WAIT_L(0); PG8_BAR; PG8_MMA(0, 0, At, B0); PG8_MMA(0, 1, At, B1); PG8_BAR; PG8_SCHED;
            PG8_LDA(At, 1, 1); PG8_STAGE(PG8_SB(1, 0), b3, voffB); PG8_STAGE(PG8_SB(1, 1), b3 + hstep, voffB); PG8_STAGE(PG8_SA(1, 0), a3, voffA);
            PG8_WAIT_V(8); PG8_WAIT_L(0); PG8_BAR; PG8_MMA(1, 0, At, B0); PG8_MMA(1, 1, At, B1); PG8_BAR; PG8_SCHED;
            } else {
            PG8_LDB(B0, 0, 0); PG8_SCHED; PG8_LDA(At, 0, 0); PG8_STAGE(PG8_SA(1, 1), a1 + hstep, voffA);
            PG8_WAIT_L(8); PG8_BAR; PG8_WAIT_L(0); PG8_MMA(0, 0, At, B0); PG8_BAR; PG8_SCHED;
            PG8_LDB(B1, 0, 1); PG8_STAGE(PG8_SB(0, 0), b2, voffB);
            PG8_BAR; PG8_WAIT_L(0); PG8_MMA(0, 1, At, B1); PG8_BAR;
            PG8_LDA(At, 0, 1); PG8_STAGE(PG8_SA(0, 0), a2, voffA);
            PG8_BAR; PG8_WAIT_L(0); PG8_MMA(1, 0, At, B0); PG8_BAR; PG8_SCHED;
            PG8_STAGE(PG8_SB(0, 1), b2 + hstep, voffB);
            PG8_WAIT_V(6); PG8_BAR; PG8_MMA(1, 1, At, B1); PG8_BAR;
            PG8_LDB(B0, 1, 0); PG8_SCHED; PG8_LDA(At, 1, 0); PG8_STAGE(PG8_SA(0, 1), a2 + hstep, voffA);
            PG8_WAIT_L(8); PG8_BAR; PG8_WAIT_L(0); PG8_MMA(0, 0, At, B0); PG8_BAR; PG8_SCHED;
            PG8_LDB(B1, 1, 1); PG8_STAGE(PG8_SB(1, 0), b3, voffB);
            PG8_BAR; PG8_WAIT_L(0); PG8_MMA(0, 1, At, B1); PG8_BAR;
            PG8_LDA(At, 1, 1); PG8_STAGE(PG8_SA(1, 0), a3, voffA);
            PG8_BAR; PG8_WAIT_L(0); PG8_MMA(1, 0, At, B0); PG8_BAR; PG8_SCHED;
            PG8_STAGE(PG8_SB(1, 1), b3 + hstep, voffB);
            PG8_WAIT_V(6); PG8_BAR; PG8_MMA(1, 1, At, B1); PG8_BAR;
            }
        }
        if constexpr (ALIGN_EPI) { if (wr == 0) PG8_BAR; }
        if constexpr (!Epi::AFTER_DRAIN) { E(acc, cur, wr, wc, fr, fq); S.done(cur); }
        if (!has_next) break;
#pragma unroll
        for (int a = 0; a < 2; ++a)
#pragma unroll
            for (int b = 0; b < 2; ++b)
#pragma unroll
                for (int m = 0; m < 4; ++m)
#pragma unroll
                    for (int n = 0; n < 2; ++n) acc[a][b][m][n] = (f32x4){0.f, 0.f, 0.f, 0.f};
        cur = nxt; cA = nA; cB = nB; ++ui;
        if constexpr (ALIGN_EPI) { if (wr == 1) PG8_BAR; }
    }
    PG8_WAIT_V(0);
    if constexpr (!ALIGN_EPI) { if (wr == 0) PG8_BAR; }
    PG8_BAR;
    if constexpr (Epi::AFTER_DRAIN) { E.fused(acc, cur, wr, wc, fr, fq, lds, wid, lane); S.done(cur); }
#undef PG8_SA
#undef PG8_SB
#undef PG8_STAGE
#undef PG8_LDA
#undef PG8_LDB
#undef PG8_MMA
#undef PG8_WAIT_V
#undef PG8_WAIT_L
#undef PG8_BAR
#undef PG8_SCHED
}
}

constexpr int NB = 8, S = 8192, D = 1024, FF = 2816, PW = 3072, M = NB * S, DEPTH = 4;
constexpr int NWAVES = 8, NTHR = 512;
#define LAS __attribute__((address_space(3)))
typedef unsigned short bf16;
typedef float f32x4 __attribute__((ext_vector_type(4)));
typedef float f32x2 __attribute__((ext_vector_type(2)));
typedef unsigned u32x4 __attribute__((ext_vector_type(4)));
typedef unsigned u32x2 __attribute__((ext_vector_type(2)));

__device__ __forceinline__ int ltid() { int t = threadIdx.x; asm volatile("" : "+v"(t)); return t; }
namespace at {
typedef short bf16x8 __attribute__((ext_vector_type(8)));
typedef short s16x4 __attribute__((ext_vector_type(4)));
typedef float f32x16 __attribute__((ext_vector_type(16)));
constexpr int KROW = 144, KBUF = 64 * KROW, VBUF = 16384, ATT_LDS = 2 * KBUF + 2 * VBUF;
constexpr float NEGF = -1e30f;
__device__ __forceinline__ unsigned cvtpk(float lo, float hi) { typedef __bf16 b2 __attribute__((ext_vector_type(2))); f32x2 v = {lo, hi}; b2 b = __builtin_convertvector(v, b2); return __builtin_bit_cast(unsigned, b); }
__device__ __forceinline__ float max3f(float a, float b, float c) { float r; asm("v_max3_f32 %0, %1, %2, %3" : "=v"(r) : "v"(a), "v"(b), "v"(c)); return r; }
__device__ __forceinline__ float partner_max(float v) { auto rr = __builtin_amdgcn_permlane32_swap(__float_as_uint(v), __float_as_uint(v), false, false); return fmaxf(__uint_as_float(rr[0]), __uint_as_float(rr[1])); }
__device__ __forceinline__ float partner_sum(float v) { auto rr = __builtin_amdgcn_permlane32_swap(__float_as_uint(v), __float_as_uint(v), false, false); return __uint_as_float(rr[0]) + __uint_as_float(rr[1]); }
__device__ __forceinline__ s16x4 vtr(const LAS unsigned char* p) { typedef short v4i16_t __attribute__((ext_vector_type(4))); return __builtin_bit_cast(s16x4, __builtin_amdgcn_ds_read_tr16_b64_v4i16((LAS v4i16_t*)p)); }
__device__ __forceinline__ bf16x8 pack8(const f32x16& p, int b) {
    u32x4 w; w.x = cvtpk(p[b], p[b + 1]); w.y = cvtpk(p[b + 2], p[b + 3]); w.z = cvtpk(p[b + 4], p[b + 5]); w.w = cvtpk(p[b + 6], p[b + 7]); return __builtin_bit_cast(bf16x8, w);
}

template <int DV>
__device__ __forceinline__ void sweep(LAS unsigned char* lds, const bf16* Kb, const bf16* Vb, size_t rstride, int t_lo, int t_hi, int W, int ql, int wq_lo,
                                      const bf16x8 (&qf)[4], f32x16 (&o)[DV / 32], float& m, float& l) {
    constexpr int NV = DV / 64, ND = DV / 32;
    const int tid = ltid(), lane = tid & 63, r32 = lane & 31, hi = lane >> 5;
    const int krow = tid >> 3, kch = tid & 7;
    const bf16* kg = Kb + (size_t)krow * rstride + kch * 8;
    const int kwoff = krow * KROW + kch * 16;
    const int vrow0 = (DV == 64) ? ((tid >> 4) * 2 + ((tid >> 2) & 1)) : ((tid >> 5) * 2 + ((tid >> 2) & 1));
    const int vch = (DV == 64) ? (((tid >> 3) & 1) * 4 + (tid & 3)) : (((tid >> 3) & 3) * 4 + (tid & 3));
    const bf16* vg = Vb + (size_t)vrow0 * rstride + vch * 8;
    int vwoff[NV];
#pragma unroll
    for (int i = 0; i < NV; ++i) { const int vr = vrow0 + 32 * i; vwoff[i] = (vch >> 2) * 4096 + (vr >> 4) * 1024 + (vr & 15) * 64 + (vch & 3) * 16; }
    const size_t tstep = (size_t)64 * rstride;
    u32x4 kregA, vregA[NV], kregB, vregB[NV];
#define AT_LOAD(KR_, VR_, T_) do { KR_ = *(const u32x4*)(kg + (size_t)(T_) * tstep); \
        _Pragma("unroll") for (int i = 0; i < NV; ++i) VR_[i] = *(const u32x4*)(vg + (size_t)(T_) * tstep + (size_t)(32 * i) * rstride); } while (0)
#define AT_WRITE(KR_, VR_) do { *(LAS u32x4*)(kbuf + kwoff) = KR_; \
        _Pragma("unroll") for (int i = 0; i < NV; ++i) *(LAS u32x4*)(vbuf + vwoff[i]) = VR_[i]; } while (0)
    AT_LOAD(kregA, vregA, t_lo);
    if (t_lo + 1 < t_hi) AT_LOAD(kregB, vregB, t_lo + 1);
    const int kroff = r32 * KROW + hi * 16;
    const int vroff = (4 * hi + ((lane & 15) >> 2)) * 64 + ((lane >> 4) & 1) * 32 + (lane & 3) * 8;
    f32x16 negm;
#pragma unroll
    for (int r = 0; r < 16; ++r) negm[r] = -m;
#define AT_TILE() do { \
        const int k0 = t * 64; \
        const bool relevant = (k0 <= wq_lo + 31) && (wq_lo - (k0 + 63) <= W); \
        if (relevant) { \
            bf16x8 kf[8]; \
_Pragma("unroll") \
            for (int d0 = 0; d0 < 4; ++d0) { kf[2 * d0] = *(const LAS bf16x8*)(kbuf + kroff + d0 * 32); kf[2 * d0 + 1] = *(const LAS bf16x8*)(kbuf + kroff + 32 * KROW + d0 * 32); } \
            f32x16 p0, p1; \
            p0 = __builtin_amdgcn_mfma_f32_32x32x16_bf16(kf[0], qf[0], negm, 0, 0, 0); \
            p1 = __builtin_amdgcn_mfma_f32_32x32x16_bf16(kf[1], qf[0], negm, 0, 0, 0); \
_Pragma("unroll") \
            for (int d0 = 1; d0 < 4; ++d0) { \
                p0 = __builtin_amdgcn_mfma_f32_32x32x16_bf16(kf[2 * d0], qf[d0], p0, 0, 0, 0); \
                p1 = __builtin_amdgcn_mfma_f32_32x32x16_bf16(kf[2 * d0 + 1], qf[d0], p1, 0, 0, 0); \
            } \
 \
            s16x4 vlo[2][4], vhh[2][4]; \
_Pragma("unroll") \
            for (int ks = 0; ks < 4; ++ks) { vlo[0][ks] = vtr(vbuf + vroff + ks * 1024); vhh[0][ks] = vtr(vbuf + vroff + ks * 1024 + 512); } \
            __builtin_amdgcn_sched_barrier(0); \
            const bool full = (k0 + 63 <= wq_lo) && (wq_lo + 31 - k0 <= W); \
            if (!full) { \
_Pragma("unroll") \
                for (int r = 0; r < 16; ++r) { \
                    const int kv = k0 + (r & 3) + 8 * (r >> 2) + 4 * hi; \
                    const bool v0 = (kv <= ql) && (ql - kv <= W), v1 = (kv + 32 <= ql) && (ql - kv - 32 <= W); \
                    p0[r] = v0 ? p0[r] : NEGF; p1[r] = v1 ? p1[r] : NEGF; \
                } \
            } \
            asm volatile("s_nop 15\n\ts_nop 7" : "+v"(p0), "+v"(p1)); \
            float rm; \
            { float a = max3f(p0[0], p0[1], p1[0]), b = max3f(p0[2], p0[3], p1[1]); a = max3f(a, p1[2], p1[3]); \
_Pragma("unroll") \
              for (int r = 4; r < 16; r += 4) { a = max3f(a, p0[r], p0[r + 1]); b = max3f(b, p0[r + 2], p0[r + 3]); a = max3f(a, p1[r], p1[r + 1]); b = max3f(b, p1[r + 2], p1[r + 3]); } \
              rm = fmaxf(a, b); } \
            rm = partner_max(rm); \
            if (__builtin_expect(__any(rm > 8.0f), 0)) { \
                const float dl = fmaxf(rm, 0.f); \
                m += dl; \
_Pragma("unroll") \
                for (int r = 0; r < 16; ++r) { p0[r] -= dl; p1[r] -= dl; negm[r] = -m; } \
                const float f = __builtin_amdgcn_exp2f(-dl); \
                l *= f; \
_Pragma("unroll") \
                for (int d = 0; d < ND; ++d) o[d] = o[d] * f; \
            } \
            float s0 = 0.f, s1 = 0.f; \
_Pragma("unroll") \
            for (int r = 0; r < 16; ++r) { p0[r] = __builtin_amdgcn_exp2f(p0[r]); p1[r] = __builtin_amdgcn_exp2f(p1[r]); s0 += p0[r]; asm volatile("" : "+v"(s0)); s1 += p1[r]; asm volatile("" : "+v"(s1)); } \
            l += s0 + s1; \
            bf16x8 pa[4]; \
            pa[0] = pack8(p0, 0); pa[1] = pack8(p0, 8); pa[2] = pack8(p1, 0); pa[3] = pack8(p1, 8); \
_Pragma("unroll") \
            for (int d = 0; d < ND; ++d) { \
                if (d + 1 < ND) { \
_Pragma("unroll") \
                    for (int ks = 0; ks < 4; ++ks) { vlo[(d + 1) & 1][ks] = vtr(vbuf + vroff + (d + 1) * 4096 + ks * 1024); vhh[(d + 1) & 1][ks] = vtr(vbuf + vroff + (d + 1) * 4096 + ks * 1024 + 512); } \
                } \
_Pragma("unroll") \
                for (int ks = 0; ks < 4; ++ks) { \
                    const s16x4 lo = vlo[d & 1][ks], hh = vhh[d & 1][ks]; \
                    const bf16x8 vf = (bf16x8){lo[0], lo[1], lo[2], lo[3], hh[0], hh[1], hh[2], hh[3]}; \
                    o[d] = __builtin_amdgcn_mfma_f32_32x32x16_bf16(vf, pa[ks], o[d], 0, 0, 0); \
                } \
                if (d + 1 < ND) __builtin_amdgcn_sched_barrier(0); \
            } \
        } \
    } while (0)

    for (int tt = t_lo, st = 0; tt < t_hi; tt += 2, ++st) {
        LAS unsigned char* kb0 = lds + (st & 1) * 2 * KBUF;
        LAS unsigned char* vb0 = lds + 4 * KBUF + (st & 1) * 2 * VBUF;
        { LAS unsigned char* kbuf = kb0; LAS unsigned char* vbuf = vb0; AT_WRITE(kregA, vregA); }
        { LAS unsigned char* kbuf = kb0 + KBUF; LAS unsigned char* vbuf = vb0 + VBUF; AT_WRITE(kregB, vregB); }
        __syncthreads();
        if (tt + 2 < t_hi) { AT_LOAD(kregA, vregA, tt + 2); AT_LOAD(kregB, vregB, tt + 3); }
        { LAS unsigned char* kbuf = kb0; LAS unsigned char* vbuf = vb0; const int t = tt; AT_TILE(); }
        { LAS unsigned char* kbuf = kb0 + KBUF; LAS unsigned char* vbuf = vb0 + VBUF; const int t = tt + 1; AT_TILE(); }
    }
#undef AT_LOAD
#undef AT_WRITE
    __syncthreads();
}

__device__ __forceinline__ void diff_unit(LAS unsigned char* lds, const bf16* proj, bf16* merged, float* stash, float lam, int b, int h, int qb, int blk) {
    const int tid = ltid(), lane = tid & 63, r32 = lane & 31, hi = lane >> 5;
    const int wid = __builtin_amdgcn_readfirstlane(tid >> 6);
    const size_t rowbase = (size_t)b * S;
    const int wq_lo = qb * 256 + wid * 32, ql = wq_lo + r32;
    const bf16* qrow = proj + (rowbase + ql) * PW + h * 128;
    const bf16* kb = proj + rowbase * PW + 512 + h * 128;
    const bf16* vb = proj + rowbase * PW + 1024 + h * 128;
    float* st = stash + ((size_t)blk * NTHR + tid) * 64;
    f32x16 o[4]; float inv = 0.f;
#pragma unroll 1
    for (int comp = 0; comp < 2; ++comp) {
        bf16x8 qf[4];
#pragma unroll
        for (int d0 = 0; d0 < 4; ++d0) qf[d0] = *(const bf16x8*)(qrow + comp * 64 + 16 * d0 + 8 * hi);
#pragma unroll
        for (int d = 0; d < 4; ++d) o[d] = (f32x16){};
        float m = 0.f, l = 0.f;
        sweep<128>(lds, kb + comp * 64, vb, (size_t)PW, 0, 4 * qb + 4, 1 << 30, ql, wq_lo, qf, o, m, l);
        l = partner_sum(l);
        inv = 1.0f / l;
        if (comp == 0) {
#pragma unroll
            for (int d = 0; d < 4; ++d)
#pragma unroll
                for (int r4 = 0; r4 < 4; ++r4)
                    *(f32x4*)(st + d * 16 + r4 * 4) = (f32x4){o[d][4 * r4] * inv, o[d][4 * r4 + 1] * inv, o[d][4 * r4 + 2] * inv, o[d][4 * r4 + 3] * inv};
        }
    }
    float ss = 0.f;
    const float li = lam * inv;
#pragma unroll
    for (int d = 0; d < 4; ++d)
#pragma unroll
        for (int r4 = 0; r4 < 4; ++r4) {
            const f32x4 s1 = *(const f32x4*)(st + d * 16 + r4 * 4);
#pragma unroll
            for (int i = 0; i < 4; ++i) { const float v = s1[i] - li * o[d][4 * r4 + i]; o[d][4 * r4 + i] = v; ss += v * v; }
        }
    ss = partner_sum(ss);
    const float rs = __builtin_amdgcn_rsqf(ss * (1.0f / 128.0f) + 1e-5f);
    bf16* orow = merged + (rowbase + ql) * D + h * 128 + 4 * hi;
#pragma unroll
    for (int d = 0; d < 4; ++d)
#pragma unroll
        for (int r4 = 0; r4 < 4; ++r4) {
            u32x2 w; w.x = cvtpk(o[d][4 * r4] * rs, o[d][4 * r4 + 1] * rs); w.y = cvtpk(o[d][4 * r4 + 2] * rs, o[d][4 * r4 + 3] * rs);
            *(u32x2*)(orow + 32 * d + 8 * r4) = w;
        }
}

__device__ __forceinline__ void dil_unit(LAS unsigned char* lds, const bf16* proj, bf16* part, f32x2* ml, int b, int head, int dil, int res, int lblk) {
    const int tid = ltid(), lane = tid & 63, r32 = lane & 31, hi = lane >> 5;
    const int wid = __builtin_amdgcn_readfirstlane(tid >> 6);
    const int wq_lo = lblk * 256 + wid * 32, ql = wq_lo + r32;
    const size_t row = (size_t)b * S + (size_t)ql * dil + res;
    const bf16* qrow = proj + row * PW + 1536 + head * 64;
    const bf16* kb = proj + ((size_t)b * S + res) * PW + 2048 + head * 64;
    const bf16* vb = proj + ((size_t)b * S + res) * PW + 2560 + head * 64;
    bf16x8 qf[4];
#pragma unroll
    for (int d0 = 0; d0 < 4; ++d0) qf[d0] = *(const bf16x8*)(qrow + 16 * d0 + 8 * hi);
    f32x16 o[2]; o[0] = (f32x16){}; o[1] = (f32x16){};
    float m = 0.f, l = 0.f;
    const int t_lo = (4 * lblk - 2) > 0 ? (4 * lblk - 2) : 0;
    sweep<64>(lds, kb, vb, (size_t)dil * PW, t_lo, 4 * lblk + 4, 128, ql, wq_lo, qf, o, m, l);
    l = partner_sum(l);
    const float inv = 1.0f / l;
    bf16* orow = part + row * 512 + head * 64 + 4 * hi;
#pragma unroll
    for (int d = 0; d < 2; ++d)
#pragma unroll
        for (int r4 = 0; r4 < 4; ++r4) {
            u32x2 w; w.x = cvtpk(o[d][4 * r4] * inv, o[d][4 * r4 + 1] * inv); w.y = cvtpk(o[d][4 * r4 + 2] * inv, o[d][4 * r4 + 3] * inv);
            *(u32x2*)(orow + 32 * d + 8 * r4) = w;
        }
    if (hi == 0) ml[row * 8 + head] = (f32x2){m, l};
}

__device__ __forceinline__ void dil_stream(LAS unsigned char* lds, const bf16* proj, bf16* part_base, f32x2* ml_base, int u0, int ustep, int utotal) {
    constexpr int ND = 2, W = 128, VB = 8192, VOFF = 6 * KBUF;
    const int tid = ltid(), lane = tid & 63, r32 = lane & 31, hi = lane >> 5;
    const int wid = __builtin_amdgcn_readfirstlane(tid >> 6);
    const int krow = tid >> 3, kch = tid & 7;
    const int kwoff = krow * KROW + kch * 16;
    const int vrow0 = (tid >> 4) * 2 + ((tid >> 2) & 1), vch = ((tid >> 3) & 1) * 4 + (tid & 3);
    const int vwoff = (vch >> 2) * 4096 + (vrow0 >> 4) * 1024 + (vrow0 & 15) * 64 + (vch & 3) * 16;
    const int kroff = r32 * KROW + hi * 16;
    const int vroff = (4 * hi + ((lane & 15) >> 2)) * 64 + ((lane >> 4) & 1) * 32 + (lane & 3) * 8;
    u32x4 kst[6], vst[6]; bf16x8 qn[4];
    int u = u0; if (u >= utotal) return;
    int cb, chead, cdil, cres, clblk, cbr;
#define DS_DECODE(U_) do { cbr = (U_) >> 11; const int rem_ = (U_) & 2047, bhd_ = rem_ >> 5, blk_ = rem_ & 31; const int sh_ = (cbr == 0) ? 5 : (cbr == 1 ? 3 : 1); \
        cdil = (cbr == 0) ? 1 : (cbr == 1 ? 4 : 16); cb = bhd_ >> 3; chead = bhd_ & 7; cres = blk_ >> sh_; clblk = blk_ & ((1 << sh_) - 1); } while (0)
#define DS_LOAD() do { const int tl_ = (4 * clblk - 2) > 0 ? (4 * clblk - 2) : 0, nt_ = 4 * clblk + 4 - tl_; \
        const bf16* base_ = proj + ((size_t)cb * S + cres) * PW + chead * 64; const size_t rs_ = (size_t)cdil * PW; \
        _Pragma("unroll") for (int j = 0; j < 6; ++j) if (j < nt_) { \
            kst[j] = *(const u32x4*)(base_ + 2048 + (size_t)((tl_ + j) * 64 + krow) * rs_ + kch * 8); \
            vst[j] = *(const u32x4*)(base_ + 2560 + (size_t)((tl_ + j) * 64 + vrow0) * rs_ + vch * 8); } \
        const bf16* q_ = proj + ((size_t)cb * S + (size_t)(clblk * 256 + wid * 32 + r32) * cdil + cres) * PW + 1536 + chead * 64 + 8 * hi; \
        _Pragma("unroll") for (int d0 = 0; d0 < 4; ++d0) qn[d0] = *(const bf16x8*)(q_ + 16 * d0); } while (0)
    DS_DECODE(u);
    DS_LOAD();
    for (;;) {
        const int t_lo = (4 * clblk - 2) > 0 ? (4 * clblk - 2) : 0, ntu = 4 * clblk + 4 - t_lo;
#pragma unroll
        for (int j = 0; j < 6; ++j) if (j < ntu) { *(LAS u32x4*)(lds + j * KBUF + kwoff) = kst[j]; *(LAS u32x4*)(lds + VOFF + j * VB + vwoff) = vst[j]; }
        bf16x8 qf[4];
#pragma unroll
        for (int d0 = 0; d0 < 4; ++d0) qf[d0] = qn[d0];
        __syncthreads();
        const int wq_lo = clblk * 256 + wid * 32, ql = wq_lo + r32;
        const size_t row = (size_t)cb * S + (size_t)ql * cdil + cres;
        const int head = chead;
        bf16* part = part_base + (size_t)cbr * M * 512; f32x2* ml = ml_base + (size_t)cbr * M * 8;
        const int un = u + ustep; const bool has_next = un < utotal;
        if (has_next) { DS_DECODE(un); DS_LOAD(); }
        f32x16 o[2]; o[0] = (f32x16){}; o[1] = (f32x16){};
        float m = 0.f, l = 0.f;
        f32x16 negm = (f32x16){};
#pragma unroll 2
        for (int j = 0; j < ntu; ++j) {
            LAS unsigned char* kbuf = lds + j * KBUF;
            LAS unsigned char* vbuf = lds + VOFF + j * VB;
            const int t = t_lo + j;
            AT_TILE();
        }
        l = partner_sum(l);
        const float inv = 1.0f / l;
        bf16* orow = part + row * 512 + head * 64 + 4 * hi;
#pragma unroll
        for (int d = 0; d < 2; ++d)
#pragma unroll
            for (int r4 = 0; r4 < 4; ++r4) {
                u32x2 w; w.x = cvtpk(o[d][4 * r4] * inv, o[d][4 * r4 + 1] * inv); w.y = cvtpk(o[d][4 * r4 + 2] * inv, o[d][4 * r4 + 3] * inv);
                *(u32x2*)(orow + 32 * d + 8 * r4) = w;
            }
        if (hi == 0) ml[row * 8 + head] = (f32x2){m, l};
        __syncthreads();
        if (!has_next) break;
        u = un;
    }
#undef DS_DECODE
#undef DS_LOAD
}
#undef AT_TILE
}

constexpr size_t MiB = (size_t)1 << 20;
constexpr size_t WS_ROPE = 1 * MiB;
constexpr size_t WS_SSP = 3 * MiB;
constexpr size_t WS_W = 8 * MiB;
constexpr size_t W_GU1 = 0, W_D1 = 11 * MiB, W_GU2 = W_D1 + 5 * MiB + 512 * 1024, W_D2 = W_GU2 + 11 * MiB, W_IN = W_D2 + 5 * MiB + 512 * 1024, W_OUT = W_IN + 6 * MiB;
constexpr size_t WS_XB = 64 * MiB;
constexpr size_t WS_PROJ = 192 * MiB;
constexpr size_t WS_MRG = 576 * MiB;
constexpr size_t WS_PART = 704 * MiB;
constexpr size_t WS_ML = 896 * MiB;
constexpr size_t WS_STASH = 908 * MiB;
constexpr size_t WS_W1 = 940 * MiB;
constexpr size_t WS_END = 984 * MiB;
constexpr int LDS_BYTES = 147456;

#define XB_TMO      128
#define XB_XCNT(j)  (256  + 64 * (j))
#define XB_XSUB(j)  (1280 + 64 * (j))
#define XB_XGEN(j)  (2304 + 64 * (j))
#define XB_TOP      3328
#define XB_TOPGEN   3392
#define XCD_BAR_WORDS 3456
#define XB_SPIN_CAP (1u << 18)

__device__ __forceinline__ unsigned xb_ld(unsigned* p)              { return __hip_atomic_load(p, __ATOMIC_RELAXED, __HIP_MEMORY_SCOPE_AGENT); }
__device__ __forceinline__ unsigned xb_add(unsigned* p, unsigned v) { return __hip_atomic_fetch_add(p, v, __ATOMIC_RELAXED, __HIP_MEMORY_SCOPE_AGENT); }
__device__ __forceinline__ unsigned xb_xcc_id() { return (unsigned)__builtin_amdgcn_s_getreg((3 << 11) | 20) & 0xFu; }
#define XB_SPIN(cond, bar) do { unsigned _sp = 0; while (cond) { __builtin_amdgcn_s_sleep(1); \
    if ((++_sp & 255u) == 0u) { if (xb_ld(&(bar)[XB_TMO])) break; if (_sp > XB_SPIN_CAP) { atomicAdd(&(bar)[XB_TMO], 1u); break; } } } } while (0)

struct XcdBarrier {
    unsigned* bar; unsigned x;
    volatile LAS unsigned* st;
};

__device__ __forceinline__ XcdBarrier xcd_barrier_post(unsigned* bar, volatile LAS unsigned* st) {
    XcdBarrier b; b.bar = bar; b.x = xb_xcc_id(); b.st = st;
    if (threadIdx.x == 0) (void)xb_add(&bar[XB_XCNT(b.x)], 1u);
    return b;
}
__device__ __forceinline__ void xcd_barrier_complete(unsigned* bar, unsigned x, unsigned& nloc, unsigned& nx) {
    const unsigned G = gridDim.x * gridDim.y * gridDim.z;
    unsigned sum, cnt, mine, sp = 0u;
    for (;;) {
        sum = 0u; cnt = 0u; mine = 0u;
#pragma unroll
        for (unsigned j = 0; j < 16; ++j) { const unsigned c = xb_ld(&bar[XB_XCNT(j)]); sum += c; cnt += (c > 0u) ? 1u : 0u; mine = (j == x) ? c : mine; }
        if (sum == G) break;
        __builtin_amdgcn_s_sleep(1);
        if ((++sp & 255u) == 0u) { if (xb_ld(&bar[XB_TMO])) break; if (sp > XB_SPIN_CAP) { atomicAdd(&bar[XB_TMO], 1u); break; } }
    }
    nloc = mine > 0u ? mine : 1u; nx = cnt > 0u ? cnt : 1u;
}

__device__ __forceinline__ void xcd_barrier(const XcdBarrier& b) {
    asm volatile("s_waitcnt vmcnt(0)" ::: "memory");
    __syncthreads();
    if (threadIdx.x == 0) {
        unsigned* bar = b.bar;
        __builtin_amdgcn_s_waitcnt(0);
        unsigned nloc = b.st[0], nx = b.st[1];
        if (nloc == 0u) { xcd_barrier_complete(bar, b.x, nloc, nx); b.st[0] = nloc; b.st[1] = nx; }
        const unsigned old = xb_add(&bar[XB_XSUB(b.x)], 1u);
        const unsigned gen = old / nloc;
        if (old + 1u == (gen + 1u) * nloc) {
            __builtin_amdgcn_fence(__ATOMIC_RELEASE, "agent");
            asm volatile("s_waitcnt vmcnt(0)" ::: "memory");
            const unsigned og = xb_add(&bar[XB_TOP], 1u);
            const unsigned tg = og / nx;
            if (og + 1u == (tg + 1u) * nx) xb_add(&bar[XB_TOPGEN], 1u);
            else XB_SPIN(xb_ld(&bar[XB_TOPGEN]) == tg, bar);
            __builtin_amdgcn_fence(__ATOMIC_ACQUIRE, "agent");
            xb_add(&bar[XB_XGEN(b.x)], 1u);
            asm volatile("s_waitcnt vmcnt(0)" ::: "memory");
        } else {
            XB_SPIN(xb_ld(&bar[XB_XGEN(b.x)]) == gen, bar);
            __builtin_amdgcn_fence(__ATOMIC_ACQUIRE, "agent");
            asm volatile("s_waitcnt vmcnt(0)" ::: "memory");
        }
    }
    __syncthreads();
}

constexpr size_t WS_BAR = 0, BAR_ZERO_BYTES = 16384;
constexpr int LDS_MISC = 131072 + 512;
struct Args { const void* in[20]; float* out; unsigned char* ws; float lam_init[4]; int ph_lo, ph_hi; };

__device__ __forceinline__ float wave_sum(float v) {
#pragma unroll
    for (int o = 1; o < 64; o <<= 1) v += __shfl_xor(v, o);
    return v;
}
__device__ __forceinline__ unsigned f2bf(float f) { unsigned u = __builtin_bit_cast(unsigned, f); return (u + 0x7fffu + ((u >> 16) & 1u)) >> 16; }
__device__ __forceinline__ unsigned pk2(float lo, float hi) { return f2bf(lo) | (f2bf(hi) << 16); }
__device__ __forceinline__ float bf2f(unsigned short h) { return __builtin_bit_cast(float, (unsigned)h << 16); }

__device__ __forceinline__ void conv_item(const float* W, int K, int N, bf16* WT, int rmode, int part, int gmode, const float* g0, const float* g1, float gs, LAS float* scr, int item, int lane) {
    const int nblk = N / 32, kb = item / nblk, nb = item % nblk, k0 = 64 * kb, n0 = 32 * nb;
#pragma unroll 8
    for (int i = 0; i < 32; ++i) {
        const int kk = 2 * i + (lane >> 5), k = k0 + kk;
        float g = 1.0f;
        if (gmode == 1) g = g0[k]; else if (gmode == 2) g = (k < 512) ? g0[k & 127] * gs : g1[k - 512];
        scr[kk * 33 + (lane & 31)] = W[(size_t)k * N + n0 + (lane & 31)] * g;
    }
    asm volatile("s_waitcnt lgkmcnt(0)" ::: "memory");
    const int c = lane & 7;
#pragma unroll
    for (int j = 0; j < 4; ++j) {
        const int nl = (lane >> 3) + 8 * j, n = n0 + nl; const LAS float* s = scr + (8 * c) * 33 + nl;
        int rowd = n;
        if (rmode == 1) rowd = ((n >> 7) << 8) + part * 128 + (n & 127);
        else if (rmode == 2) { const int cc = n & 255; rowd = (n & ~255) + ((cc >> 5) & 1) * 128 + (cc >> 6) * 32 + (cc & 31); }
        u32x4 o; o.x = pk2(s[0 * 33], s[1 * 33]); o.y = pk2(s[2 * 33], s[3 * 33]); o.z = pk2(s[4 * 33], s[5 * 33]); o.w = pk2(s[6 * 33], s[7 * 33]);
        *(u32x4*)(WT + (size_t)rowd * K + k0 + 8 * c) = o;
    }
    asm volatile("s_waitcnt lgkmcnt(0)" ::: "memory");
}

typedef const Args __attribute__((address_space(4)))* ArgsP;
__device__ __forceinline__ void convert_layer(ArgsP ap, int l, LAS unsigned char* lds, int gw, int ngw, int wave, int lane) {
    LAS float* scr = (LAS float*)(lds + wave * 16384);
    unsigned char* wb = ap->ws + ((l & 1) ? WS_W1 : WS_W);
    constexpr int I_G = (D / 64) * (FF / 32), I_D = (FF / 64) * (D / 32), I_IN = (D / 64) * (PW / 32), I_OUT = (D / 64) * (D / 32);
    constexpr int NITEMS = 4 * I_G + 2 * I_D + I_IN + I_OUT;
    const size_t wgu = (size_t)D * FF;
    const float* n1 = (const float*)ap->in[2] + l * D; const float* n2 = (const float*)ap->in[15] + l * D; const float* nm = (const float*)ap->in[6] + l * D;
    for (int it = gw; it < NITEMS; it += ngw) {
        int r = it;
        if (r < I_G) { conv_item((const float*)ap->in[3] + l * wgu, D, FF, (bf16*)(wb + W_GU1), 1, 0, 1, n1, nullptr, 1.f, scr, r, lane); continue; } r -= I_G;
        if (r < I_G) { conv_item((const float*)ap->in[4] + l * wgu, D, FF, (bf16*)(wb + W_GU1), 1, 1, 1, n1, nullptr, 1.f, scr, r, lane); continue; } r -= I_G;
        if (r < I_D) { conv_item((const float*)ap->in[5] + l * wgu, FF, D, (bf16*)(wb + W_D1), 0, 0, 0, nullptr, nullptr, 1.f, scr, r, lane); continue; } r -= I_D;
        if (r < I_G) { conv_item((const float*)ap->in[16] + l * wgu, D, FF, (bf16*)(wb + W_GU2), 1, 0, 1, n2, nullptr, 1.f, scr, r, lane); continue; } r -= I_G;
        if (r < I_G) { conv_item((const float*)ap->in[17] + l * wgu, D, FF, (bf16*)(wb + W_GU2), 1, 1, 1, n2, nullptr, 1.f, scr, r, lane); continue; } r -= I_G;
        if (r < I_D) { conv_item((const float*)ap->in[18] + l * wgu, FF, D, (bf16*)(wb + W_D2), 0, 0, 0, nullptr, nullptr, 1.f, scr, r, lane); continue; } r -= I_D;
        if (r < I_IN) { conv_item((const float*)ap->in[7] + (size_t)l * D * PW, D, PW, (bf16*)(wb + W_IN), 2, 0, 1, nm, nullptr, 1.f, scr, r, lane); continue; } r -= I_IN;
        conv_item((const float*)ap->in[14] + (size_t)l * D * D, D, D, (bf16*)(wb + W_OUT), 0, 0, 2, (const float*)ap->in[12] + l * 128, (const float*)ap->in[13] + l * 512, 1.0f - ap->lam_init[l], scr, r, lane);
    }
}

__global__ void __launch_bounds__(NTHR, 2) mega(Args a) {
    extern __shared__ __attribute__((aligned(16))) unsigned char lds_raw[];
    LAS unsigned char* lds = (LAS unsigned char*)lds_raw;
    const int ph_lo = a.ph_lo, ph_hi = a.ph_hi;
    volatile LAS unsigned* bst = (volatile LAS unsigned*)(lds + LDS_MISC);
    if (threadIdx.x < 2) bst[threadIdx.x] = 0u;
    __syncthreads();
    XcdBarrier bar; bar.bar = (unsigned*)(a.ws + WS_BAR); bar.x = 0; bar.st = bst;
    if (ph_hi - ph_lo > 1) bar = xcd_barrier_post((unsigned*)(a.ws + WS_BAR), bst);
    for (int ph = ph_lo; ph < ph_hi; ++ph) {
        const int tid = ltid(), lane = tid & 63, wave = __builtin_amdgcn_readfirstlane(tid >> 6);
        int G = gridDim.x, bx = blockIdx.x; asm volatile("" : "+s"(G), "+s"(bx));
        const int vcu = (G % 8 == 0) ? (bx % 8) * (G / 8) + bx / 8 : bx;
        const int gw = vcu * NWAVES + wave, ngw = G * NWAVES;
        ArgsP ap = (ArgsP)__builtin_amdgcn_kernarg_segment_ptr();
        asm volatile("" : "+s"(ap));
        unsigned char* ws = ap->ws;
        float* X = ap->out;
        bf16* XB = (bf16*)(ws + WS_XB);
        float* ssp = (float*)(ws + WS_SSP);
        float* cs = (float*)(ws + WS_ROPE);
        bf16* PROJ = (bf16*)(ws + WS_PROJ);
        bf16* HB = (bf16*)(ws + WS_PROJ);
        bf16* MRG = (bf16*)(ws + WS_MRG);
        if (ph == 0) {
            const float* xin = (const float*)ap->in[0];
            for (int row = gw; row < M; row += ngw) {
                const f32x4* xr = (const f32x4*)(xin + (size_t)row * D) + lane;
                u32x2* xb = (u32x2*)(XB + (size_t)row * D) + lane;
                float s = 0.f;
#pragma unroll
                for (int j = 0; j < 4; ++j) {
                    const f32x4 v = xr[64 * j]; s += (v[0] * v[0] + v[1] * v[1]) + (v[2] * v[2] + v[3] * v[3]);
                    u32x2 w; w.x = pk2(v[0], v[1]); w.y = pk2(v[2], v[3]); xb[64 * j] = w;
                }
                s = wave_sum(s);
                if (lane < 16) ssp[(size_t)row * 16 + lane] = (lane == 0) ? s : 0.f;
            }
            const int* pos = (const int*)ap->in[1];
            for (int idx = bx * NTHR + tid; idx < S * 32; idx += G * NTHR) {
                const int s_ = idx >> 5, j = idx & 31;
                double inv = 1.0; for (int q = 0; q < j; ++q) inv *= 0.7498942093324559;
                const float invf = (float)inv;
                const float angf = (float)pos[s_] * invf;
                const double ang = (double)angf;
                const double kk = __builtin_rint(ang * 0.15915494309189535);
                const double r = ang - kk * 6.283185307179586;
                const double x2 = r * r;
                double c = 1.0, sn = r, tc = 1.0, ts = r;
#pragma unroll
                for (int k = 1; k <= 14; ++k) { tc *= -x2 / (double)((2 * k - 1) * (2 * k)); c += tc; ts *= -x2 / (double)((2 * k) * (2 * k + 1)); sn += ts; }
                cs[(size_t)s_ * 64 + j] = (float)c; cs[(size_t)s_ * 64 + 32 + j] = (float)sn;
            }
            convert_layer(ap, 0, lds, gw, ngw, wave, lane);
        } else if (ph == 1 + 8 * DEPTH) {
            const float* g = (const float*)ap->in[19];
            for (int row = gw; row < M; row += ngw) {
                const u32x2* xb = (const u32x2*)(XB + (size_t)row * D) + lane;
                f32x4* xo = (f32x4*)(X + (size_t)row * D) + lane;
                f32x4 v[4]; float s = 0.f;
#pragma unroll
                for (int j = 0; j < 4; ++j) { const u32x2 w = xb[64 * j];
                    v[j] = (f32x4){__builtin_bit_cast(float, w.x << 16), __builtin_bit_cast(float, w.x & 0xffff0000u), __builtin_bit_cast(float, w.y << 16), __builtin_bit_cast(float, w.y & 0xffff0000u)};
                    s += (v[j][0] * v[j][0] + v[j][1] * v[j][1]) + (v[j][2] * v[j][2] + v[j][3] * v[j][3]); }
                const float rs = 1.0f / sqrtf(wave_sum(s) * (1.0f / D) + 1e-6f);
#pragma unroll
                for (int j = 0; j < 4; ++j) { const f32x4 gg = ((const f32x4*)g)[lane + 64 * j]; xo[64 * j] = v[j] * rs * gg; }
            }
        } else {
            const int l = (ph - 1) / 8, k = (ph - 1) % 8;
            unsigned char* wb = ws + ((l & 1) ? WS_W1 : WS_W);
            if (k == 0 || k == 6) {
                pg8::Gemm g{XB, (const bf16*)(wb + (k == 0 ? W_GU1 : W_GU2)), M, 2 * FF, D};
                pg8::StaticOrder SO; SO.init(M, 2 * FF, G, bx);
                pg8::EpiGU E{HB, ssp, FF};
#ifndef SK_GU
                for (int rep_ = 0; rep_ < REP_GU; ++rep_)
                pg8::gemm_phase<pg8::EpiGU, pg8::StaticOrder, true, true>(lds, g, SO, E);
#endif
            } else if (k == 1 || k == 7 || k == 5) {
                pg8::Gemm g{k == 5 ? MRG : HB, (const bf16*)(wb + (k == 1 ? W_D1 : (k == 7 ? W_D2 : W_OUT))), M, D, k == 5 ? D : FF};
                pg8::StaticOrder SO; SO.init(M, D, G, bx);
#ifndef SK_RES
                for (int rep_ = 0; rep_ < REP_RES; ++rep_) {
                pg8::EpiRes E{XB, ssp, rep_ + 1 < REP_RES ? 0.0f : (k == 5 ? 1.0f : 0.5f)};
                pg8::gemm_phase<pg8::EpiRes, pg8::StaticOrder, true, true>(lds, g, SO, E);
                }
#endif
            } else if (k == 2) {
                pg8::Gemm g{XB, (const bf16*)(wb + W_IN), M, PW, D};
                pg8::StaticOrder SO; SO.init(M, PW, G, bx);
                pg8::EpiProj E{PROJ, ssp, cs};
#ifndef SK_PROJ
                for (int rep_ = 0; rep_ < REP_PROJ; ++rep_)
                pg8::gemm_phase<pg8::EpiProj, pg8::StaticOrder, true, true>(lds, g, SO, E);
#endif
            } else if (k == 3) {
                float s1 = ((const float*)ap->in[8])[l * 64 + lane] * ((const float*)ap->in[9])[l * 64 + lane];
                float s2 = ((const float*)ap->in[10])[l * 64 + lane] * ((const float*)ap->in[11])[l * 64 + lane];
                s1 = wave_sum(s1); s2 = wave_sum(s2);
                const float lam = expf(s1) - expf(s2) + ap->lam_init[l];
                float* stash = (float*)(ws + WS_STASH);
              for (int rep_ = 0; rep_ < REP_DIFF; ++rep_)
                for (int r = 0; r < 4; ++r) {
                    const int per = G >> 3, xcd = vcu / per, i = vcu % per;
                    const int bh = (xcd * 4 + r) & 31, qb = ((r & 1) ? 31 - i : i) & 31;
#ifndef SK_DIFF
                    if (per == 32 && (G & 7) == 0) at::diff_unit(lds, PROJ, MRG, stash, lam, bh >> 2, bh & 3, qb, bx);
#endif
                }
              if ((G >> 3) != 32 || (G & 7))
                for (int pi = vcu; pi < 512; pi += G)
#pragma unroll 1
                    for (int i = 0; i < 2; ++i) { const int bh = pi >> 4, s_ = pi & 15, qb = i ? 31 - s_ : s_; at::diff_unit(lds, PROJ, MRG, stash, lam, bh >> 2, bh & 3, qb, bx); }
              for (int rep_ = 0; rep_ < REP_DIL; ++rep_)
                at::dil_stream(lds, PROJ, (bf16*)(ws + WS_PART), (f32x2*)(ws + WS_ML), vcu, G, 6144);
                for (int rep_ = 0; rep_ < REP_MISC; ++rep_)
                if (l + 1 < DEPTH) convert_layer(ap, l + 1, lds, gw, ngw, wave, lane);
            } else if (k == 4) {
                const bf16* part = (const bf16*)(ws + WS_PART); const f32x2* ml = (const f32x2*)(ws + WS_ML);
                for (int rep_ = 0; rep_ < REP_MISC; ++rep_)
                for (int row = gw; row < M; row += ngw) {
                    u32x4 pv[3]; f32x2 mv[3];
#pragma unroll
                    for (int b = 0; b < 3; ++b) { pv[b] = *(const u32x4*)(part + ((size_t)b * M + row) * 512 + 8 * lane); mv[b] = ml[((size_t)b * M + row) * 8 + (lane >> 3)]; }
                    const float mall = fmaxf(mv[0].x, fmaxf(mv[1].x, mv[2].x));
                    float w[3], wsum = 0.f;
#pragma unroll
                    for (int b = 0; b < 3; ++b) { w[b] = mv[b].y * __builtin_amdgcn_exp2f(mv[b].x - mall); wsum += w[b]; }
                    const float iw = 1.0f / wsum;
                    float o[8]; float ss = 0.f;
#pragma unroll
                    for (int i = 0; i < 8; ++i) {
                        float acc = 0.f;
#pragma unroll
                        for (int b = 0; b < 3; ++b) { const unsigned wd = pv[b][i >> 1]; acc += w[b] * bf2f((unsigned short)((i & 1) ? (wd >> 16) : (wd & 0xffffu))); }
                        o[i] = acc * iw; ss += o[i] * o[i];
                    }
                    const float rs = __builtin_amdgcn_rsqf(wave_sum(ss) * (1.0f / 512.0f) + 1e-6f);
                    u32x4 wv; wv.x = pk2(o[0] * rs, o[1] * rs); wv.y = pk2(o[2] * rs, o[3] * rs); wv.z = pk2(o[4] * rs, o[5] * rs); wv.w = pk2(o[6] * rs, o[7] * rs);
                    *(u32x4*)(MRG + (size_t)row * D + 512 + 8 * lane) = wv;
                }
            }
        }
        if (ph + 1 < ph_hi) {
            for (int rep_ = 0; rep_ < REP_SYNC; ++rep_) { if (ph == ph_lo) cg::this_grid().sync(); else xcd_barrier(bar); }
        }
    }
}

extern "C" void kernel_launch(void* const* d_in, const int* in_sizes, int n_in, void* d_out, int out_size, void* d_ws, size_t ws_size, hipStream_t stream) {
    static int grid = 0;
    if (grid == 0) {
        if (n_in != 20 || out_size != M * D || ws_size < WS_END) { fprintf(stderr, "kernel_launch: unexpected problem (n_in %d, out %d, ws %zu)\n", n_in, out_size, ws_size); grid = -1; return; }
        int dev = 0, cus = 0, per_cu = 0;
        hipGetDevice(&dev);
        hipDeviceGetAttribute(&cus, hipDeviceAttributeMultiprocessorCount, dev);
        if (hipFuncSetAttribute((const void*)mega, hipFuncAttributeMaxDynamicSharedMemorySize, LDS_BYTES) != hipSuccess) { fprintf(stderr, "kernel_launch: hipFuncSetAttribute failed\n"); grid = -1; return; }
        if (hipOccupancyMaxActiveBlocksPerMultiprocessor(&per_cu, (const void*)mega, NTHR, LDS_BYTES) != hipSuccess || per_cu < 1) { fprintf(stderr, "kernel_launch: occupancy query says %d\n", per_cu); per_cu = 1; (void)hipGetLastError(); }
        grid = cus * per_cu;
    }
    if (grid < 0) return;
    Args a{};
    for (int i = 0; i < 20; ++i) a.in[i] = d_in[i];
    a.out = (float*)d_out; a.ws = (unsigned char*)d_ws;
    a.lam_init[0] = 0.2f; a.lam_init[1] = (float)(0.8 - 0.6 * 0.7408182206817179); a.lam_init[2] = (float)(0.8 - 0.6 * 0.5488116360940264); a.lam_init[3] = (float)(0.8 - 0.6 * 0.4065696597405991);
    constexpr int NPH = 2 + 8 * DEPTH;
#if MK_PER_PHASE
    for (int ph = 0; ph < NPH; ++ph) {
        a.ph_lo = ph; a.ph_hi = ph + 1;
        hipLaunchKernelGGL(mega, dim3(grid), dim3(NTHR), LDS_BYTES, stream, a);
    }
#else
    a.ph_lo = 0; a.ph_hi = NPH;
    if (hipMemsetAsync((char*)d_ws + WS_BAR, 0, BAR_ZERO_BYTES, stream) != hipSuccess) { fprintf(stderr, "kernel_launch: hipMemsetAsync failed\n"); return; }
    void* args[] = {&a};
    hipError_t e = hipLaunchCooperativeKernel((const void*)mega, dim3(grid), dim3(NTHR), args, LDS_BYTES, stream);
    if (e != hipSuccess) fprintf(stderr, "kernel_launch: cooperative launch failed: %s (grid %d)\n", hipGetErrorString(e), grid);
#endif
}
```

```cpp
#include <hip/hip_runtime.h>
#include <hip/hip_cooperative_groups.h>
#include <cstdio>
#include <cstdint>
namespace cg = cooperative_groups;
#ifndef MK_PER_PHASE
#define MK_PER_PHASE 0
#endif
#ifndef REP_DIFF
#define REP_DIFF 1
#endif
#ifndef REP_DIL
#define REP_DIL 1
#endif
#ifndef REP_GU
#define REP_GU 1
#endif
#ifndef REP_PROJ
#define REP_PROJ 1
#endif
#ifndef REP_RES
#define REP_RES 1
#endif
#ifndef REP_MISC
#define REP_MISC 1
#endif
#ifndef REP_SYNC
#define REP_SYNC 1
#endif
namespace pg8 {
#define PG8_LAS __attribute__((address_space(3)))
typedef unsigned short bf16_t;
typedef short bf16x8 __attribute__((ext_vector_type(8)));
typedef float f32x4 __attribute__((ext_vector_type(4)));
typedef unsigned u32x4 __attribute__((ext_vector_type(4)));
constexpr int BM = 256, BK = 64, HALF = 128, HTB = HALF * BK * 2  , STAGE_BYTES = 8 * HTB, NXCD = 8, WGM = 4;

__host__ __device__ __forceinline__ int lds_byte(int r, int c) { const int st = (r >> 4) * 2 + (c >> 5), rr = r & 15, cc = c & 31, ob = rr * 64 + cc * 2; return st * 1024 + (ob ^ (((ob >> 9) & 1) << 5)); }
__host__ __device__ __forceinline__ void stage_rc(int b, int& R, int& C) { const int st = b / 1024, sb = b % 1024, swz = sb ^ (((sb >> 9) & 1) << 5); R = (st >> 1) * 16 + swz / 64; C = (st & 1) * 32 + (swz % 64) / 2; }
__host__ __device__ __forceinline__ int perm32(int rho) { const int n = rho >> 4, i = rho & 15; return 8 * (i >> 2) + 4 * n + (i & 3); }

struct Unit { int pm, pn; };
struct Gemm { const bf16_t* A; const bf16_t* Bt; int M, N, K; };

struct StaticOrder {
    int nM, nN, nwg, G, c;
    __host__ __device__ void init(int M, int N, int G_, int c_) { nM = M / BM; nN = N / BM; nwg = nM * nN; G = G_; c = c_; }
    __host__ __device__ bool next(int i, Unit& u) const {
        const long L = (long)i * G + c; if (L >= nwg) return false;
        int wgid = (int)L; { const int q = nwg / NXCD, r = nwg % NXCD, xcd = wgid % NXCD, off = wgid / NXCD; wgid = (xcd < r ? xcd * (q + 1) : r * (q + 1) + (xcd - r) * q) + off; }
        const int nig = WGM * nN, gid = wgid / nig, fm = gid * WGM, gsz = (nM - fm) < WGM ? (nM - fm) : WGM;
        u.pm = fm + ((wgid % nig) % gsz); u.pn = (wgid % nig) / gsz; return true;
    }
    __device__ __forceinline__ void a_ready(const Unit&) const {}
    __device__ __forceinline__ void done(const Unit&) const {}
};
__device__ __forceinline__ unsigned cvt_pk_bf16(float lo, float hi) { unsigned r; asm volatile("v_cvt_pk_bf16_f32 %0, %1, %2" : "=v"(r) : "v"(lo), "v"(hi)); return r; }
typedef float f32x2 __attribute__((ext_vector_type(2)));
typedef unsigned u32x2 __attribute__((ext_vector_type(2)));
constexpr int NSSP = 16;
__device__ __forceinline__ void rows_rstd(float (&rs)[8], const float* ssp, int row0, int fq, float mul) {
    f32x4 v[8];
#pragma unroll
    for (int j = 0; j < 8; ++j) v[j] = ((const f32x4*)(ssp + (size_t)(row0 + (j >> 2) * HALF + (j & 3) * 16) * NSSP))[fq];
#pragma unroll
    for (int j = 0; j < 8; ++j) {
        float t = (v[j][0] + v[j][1]) + (v[j][2] + v[j][3]);
        t += __shfl_xor(t, 16); t += __shfl_xor(t, 32);
        rs[j] = mul * __builtin_amdgcn_rsqf(t * (1.0f / 1024.0f) + 1e-6f);
    }
}
struct EpiGU {
    static constexpr bool PERM = true, AFTER_DRAIN = false;
    bf16_t* H; const float* ssp; int ldh;
    __device__ __forceinline__ void operator()(const f32x4 (&acc)[2][2][4][2], const Unit& u, int wr, int wc, int fr_, int fq_) const {
        int fr = fr_, fq = fq_; asm volatile("" : "+v"(fr), "+v"(fq));
        const int row0 = u.pm * BM + wr * 64 + fr, col0 = u.pn * HALF + wc * 32 + 8 * fq;
        float rsv[8]; rows_rstd(rsv, ssp, row0, fq, 1.0f);
#pragma unroll
        for (int ai = 0; ai < 2; ++ai)
#pragma unroll
            for (int m = 0; m < 4; ++m) {
                const int row = row0 + ai * HALF + m * 16;
                const float rs = rsv[ai * 4 + m], rsn = -1.4426950408889634f * rs, rs2 = rs * rs;
                f32x2 t[4], ab[4];
#pragma unroll
                for (int q = 0; q < 4; ++q) {
                    const f32x2 a2 = (f32x2){acc[ai][0][m][q >> 1][(2 * q) & 3], acc[ai][0][m][q >> 1][(2 * q + 1) & 3]};
                    const f32x2 b2 = (f32x2){acc[ai][1][m][q >> 1][(2 * q) & 3], acc[ai][1][m][q >> 1][(2 * q + 1) & 3]};
                    t[q] = a2 * rsn; ab[q] = (a2 * b2) * rs2;
                }
#pragma unroll
                for (int q = 0; q < 4; ++q) { t[q].x = __builtin_amdgcn_exp2f(t[q].x); t[q].y = __builtin_amdgcn_exp2f(t[q].y); }
#pragma unroll
                for (int q = 0; q < 4; ++q) t[q] = t[q] + 1.0f;
#pragma unroll
                for (int q = 0; q < 4; ++q) { t[q].x = __builtin_amdgcn_rcpf(t[q].x); t[q].y = __builtin_amdgcn_rcpf(t[q].y); }
#pragma unroll
                for (int q = 0; q < 4; ++q) ab[q] = ab[q] * t[q];
                u32x4 w; w.x = cvt_pk_bf16(ab[0].x, ab[0].y); w.y = cvt_pk_bf16(ab[1].x, ab[1].y); w.z = cvt_pk_bf16(ab[2].x, ab[2].y); w.w = cvt_pk_bf16(ab[3].x, ab[3].y);
                __builtin_nontemporal_store(w, (u32x4*)(H + (size_t)row * ldh + col0));
            }
    }
};
struct EpiRes {
    static constexpr bool PERM = true, AFTER_DRAIN = false;
    bf16_t* XB; float* ssp; float scale;
    __device__ __forceinline__ void operator()(const f32x4 (&acc)[2][2][4][2], const Unit& u, int wr, int wc, int fr_, int fq_) const {
        int fr = fr_, fq = fq_; asm volatile("" : "+v"(fr), "+v"(fq));
        const int row0 = u.pm * BM + wr * 64 + fr, col0 = u.pn * BM + wc * 32 + 8 * fq;
#pragma unroll
        for (int ai = 0; ai < 2; ++ai) {
            u32x4 xv[4][2];
#pragma unroll
            for (int m = 0; m < 4; ++m)
#pragma unroll
                for (int bj = 0; bj < 2; ++bj) xv[m][bj] = *(const u32x4*)(XB + (size_t)(row0 + ai * HALF + m * 16) * 1024 + col0 + bj * HALF);
#pragma unroll
            for (int m = 0; m < 4; ++m) {
                const int row = row0 + ai * HALF + m * 16;
                f32x2 ss2 = (f32x2){0.f, 0.f};
#pragma unroll
                for (int bj = 0; bj < 2; ++bj) {
                    f32x2 o2[4];
#pragma unroll
                    for (int q = 0; q < 4; ++q) {
                        const unsigned wd = xv[m][bj][q];
                        const f32x2 x2 = (f32x2){__builtin_bit_cast(float, wd << 16), __builtin_bit_cast(float, wd & 0xffff0000u)};
                        const f32x2 a2 = (f32x2){acc[ai][bj][m][q >> 1][(2 * q) & 3], acc[ai][bj][m][q >> 1][(2 * q + 1) & 3]};
                        o2[q] = x2 + a2 * scale;
                    }
#pragma unroll
                    for (int q = 0; q < 4; ++q) ss2 = ss2 + o2[q] * o2[q];
                    u32x4 w; w.x = cvt_pk_bf16(o2[0].x, o2[0].y); w.y = cvt_pk_bf16(o2[1].x, o2[1].y); w.z = cvt_pk_bf16(o2[2].x, o2[2].y); w.w = cvt_pk_bf16(o2[3].x, o2[3].y);
                    *(u32x4*)(XB + (size_t)row * 1024 + col0 + bj * HALF) = w;
                }
                float ss = ss2.x + ss2.y;
                ss += __shfl_xor(ss, 16); ss += __shfl_xor(ss, 32);
                if (fq == 0) ssp[(size_t)row * NSSP + u.pn * 4 + wc] = ss;
            }
            asm volatile("" ::: "memory");
        }
    }
};
struct EpiProj {
    static constexpr bool PERM = true, AFTER_DRAIN = false;
    bf16_t* P; const float* ssp; const float* cs;
    __device__ __forceinline__ void operator()(const f32x4 (&acc)[2][2][4][2], const Unit& u, int wr, int wc, int fr_, int fq_) const {
        int fr = fr_, fq = fq_; asm volatile("" : "+v"(fr), "+v"(fq));
        const int row0 = u.pm * BM + wr * 64 + fr;
        const int t = u.pn;
        const bool rope = !(t == 4 || t == 5 || t == 10 || t == 11);
        const float qs = (t < 2 || t == 6 || t == 7) ? 0.125f * 1.4426950408889634f : 1.0f;
        const int colL = t * BM + wc * 64 + 8 * fq;
        float rsv[8]; rows_rstd(rsv, ssp, row0, fq, qs);
#pragma unroll
        for (int hb = 0; hb < 4; ++hb) {
            const int ai = hb >> 1;
            f32x4 cv[2][4];
            if (rope) {
#pragma unroll
                for (int mm = 0; mm < 2; ++mm) {
                    const int m = (hb & 1) * 2 + mm;
                    const float* cp = cs + (size_t)((row0 + ai * HALF + m * 16) & 8191) * 64 + 8 * fq;
                    cv[mm][0] = *(const f32x4*)(cp); cv[mm][1] = *(const f32x4*)(cp + 4); cv[mm][2] = *(const f32x4*)(cp + 32); cv[mm][3] = *(const f32x4*)(cp + 36);
                }
            }
#pragma unroll
            for (int mm = 0; mm < 2; ++mm) {
                const int m = (hb & 1) * 2 + mm;
                const int row = row0 + ai * HALF + m * 16;
                const float rs = rsv[ai * 4 + m];
                f32x2 o1[4], o2[4];
                if (rope) {
                    const f32x4 c0 = cv[mm][0], c1 = cv[mm][1], s0 = cv[mm][2], s1 = cv[mm][3];
                    f32x2 C[4], Sn[4];
                    C[0] = (f32x2){c0[0], c0[1]} * rs; C[1] = (f32x2){c0[2], c0[3]} * rs; C[2] = (f32x2){c1[0], c1[1]} * rs; C[3] = (f32x2){c1[2], c1[3]} * rs;
                    Sn[0] = (f32x2){s0[0], s0[1]} * rs; Sn[1] = (f32x2){s0[2], s0[3]} * rs; Sn[2] = (f32x2){s1[0], s1[1]} * rs; Sn[3] = (f32x2){s1[2], s1[3]} * rs;
#pragma unroll
                    for (int q = 0; q < 4; ++q) {
                        const f32x2 a2 = (f32x2){acc[ai][0][m][q >> 1][(2 * q) & 3], acc[ai][0][m][q >> 1][(2 * q + 1) & 3]};
                        const f32x2 b2 = (f32x2){acc[ai][1][m][q >> 1][(2 * q) & 3], acc[ai][1][m][q >> 1][(2 * q + 1) & 3]};
                        o1[q] = a2 * C[q] - b2 * Sn[q]; o2[q] = a2 * Sn[q] + b2 * C[q];
                    }
                } else {
#pragma unroll
                    for (int q = 0; q < 4; ++q) {
                        o1[q] = (f32x2){acc[ai][0][m][q >> 1][(2 * q) & 3], acc[ai][0][m][q >> 1][(2 * q + 1) & 3]} * rs;
                        o2[q] = (f32x2){acc[ai][1][m][q >> 1][(2 * q) & 3], acc[ai][1][m][q >> 1][(2 * q + 1) & 3]} * rs;
                    }
                }
                u32x4 w1, w2;
                w1.x = cvt_pk_bf16(o1[0].x, o1[0].y); w1.y = cvt_pk_bf16(o1[1].x, o1[1].y); w1.z = cvt_pk_bf16(o1[2].x, o1[2].y); w1.w = cvt_pk_bf16(o1[3].x, o1[3].y);
                w2.x = cvt_pk_bf16(o2[0].x, o2[0].y); w2.y = cvt_pk_bf16(o2[1].x, o2[1].y); w2.z = cvt_pk_bf16(o2[2].x, o2[2].y); w2.w = cvt_pk_bf16(o2[3].x, o2[3].y);
                bf16_t* pr = P + (size_t)row * 3072 + colL;
                __builtin_nontemporal_store(w1, (u32x4*)(pr)); __builtin_nontemporal_store(w2, (u32x4*)(pr + 32));
            }
            asm volatile("" ::: "memory");
        }
    }
};
template <class Epi, class Sched, bool ALIGN_EPI = false, bool SP2 = false>
__device__ __forceinline__ void gemm_phase(PG8_LAS unsigned char* lds, const Gemm g, const Sched& S, const Epi& E) {
    int tid_ = threadIdx.x; asm volatile("" : "+v"(tid_));
    const int tid = tid_, wid = __builtin_amdgcn_readfirstlane(tid >> 6), lane = tid & 63, wr = wid >> 2, wc = wid & 3, fr = lane & 15, fq = lane >> 4;
    const int K = g.K, nt = K / BK;
    unsigned voffA[2], voffB[2];
#pragma unroll
    for (int i = 0; i < 2; ++i) { int R, C; stage_rc(tid * 16 + i * 8192, R, C); const int Rb = Epi::PERM ? ((R & ~31) + perm32(R & 31)) : R;
        voffA[i] = (unsigned)(R * K + C) * 2u; voffB[i] = (unsigned)(Rb * K + C) * 2u; }
    const size_t kstep = (size_t)(BK * 2);
    const size_t hstep = (size_t)HALF * K * 2;
    const size_t tstep = 2 * hstep;
    const unsigned ldsw = (unsigned)wid * 1024u;
    const int aoff = lds_byte(wr * 64 + fr, fq * 8), boff = lds_byte(wc * 32 + fr, fq * 8);
#define PG8_SA(b, h) (((b) * 2 + (h)) * HTB)
#define PG8_SB(b, h) ((4 + (b) * 2 + (h)) * HTB)
#define PG8_STAGE(bufoff, gbase, voff) do { _Pragma("unroll") for (int _i = 0; _i < 2; ++_i) \
        __builtin_amdgcn_global_load_lds((const unsigned*)((const char*)(gbase) + (voff)[_i]), (PG8_LAS unsigned*)(lds + (bufoff) + ldsw + _i * 8192), 16, 0, 0); } while (0)
#define PG8_LDA(dst, b, h) do { _Pragma("unroll") for (int m = 0; m < 4; ++m) _Pragma("unroll") for (int k = 0; k < 2; ++k) dst[m][k] = *(const PG8_LAS bf16x8*)(lds + PG8_SA(b, h) + aoff + m * 2048 + k * 1024); } while (0)
#define PG8_LDB(dst, b, h) do { _Pragma("unroll") for (int n = 0; n < 2; ++n) _Pragma("unroll") for (int k = 0; k < 2; ++k) dst[n][k] = *(const PG8_LAS bf16x8*)(lds + PG8_SB(b, h) + boff + n * 2048 + k * 1024); } while (0)
#define PG8_MMA(ai, bj, At, Bt) do { __builtin_amdgcn_s_setprio(1); _Pragma("unroll") for (int m = 0; m < 4; ++m) _Pragma("unroll") for (int n = 0; n < 2; ++n) _Pragma("unroll") for (int k = 0; k < 2; ++k) \
        acc[ai][bj][m][n] = __builtin_amdgcn_mfma_f32_16x16x32_bf16(Bt[n][k], At[m][k], acc[ai][bj][m][n], 0, 0, 0); __builtin_amdgcn_s_setprio(0); } while (0)
#define PG8_WAIT_V(n) asm volatile("s_waitcnt vmcnt(" #n ")" ::: "memory")
#define PG8_WAIT_L(n) asm volatile("s_waitcnt lgkmcnt(" #n ")" ::: "memory")
#define PG8_BAR __builtin_amdgcn_s_barrier()
#define PG8_SCHED __builtin_amdgcn_sched_barrier(0)
    Unit cur, nxt; int ui = 0;
    if (!S.next(0, cur)) return;
    f32x4 acc[2][2][4][2];
#pragma unroll
    for (int a = 0; a < 2; ++a)
#pragma unroll
        for (int b = 0; b < 2; ++b)
#pragma unroll
            for (int m = 0; m < 4; ++m)
#pragma unroll
                for (int n = 0; n < 2; ++n) acc[a][b][m][n] = (f32x4){0.f, 0.f, 0.f, 0.f};
    bf16x8 At[4][2], B0[2][2], B1[2][2];
    const char* cA = (const char*)g.A + (size_t)cur.pm * tstep; const char* cB = (const char*)g.Bt + (size_t)cur.pn * tstep;
    S.a_ready(cur);
    if constexpr (SP2) {
        PG8_STAGE(PG8_SB(0, 0), cB, voffB); PG8_STAGE(PG8_SB(0, 1), cB + hstep, voffB); PG8_STAGE(PG8_SA(0, 0), cA, voffA); PG8_STAGE(PG8_SA(0, 1), cA + hstep, voffA);
        if (wr == 1) PG8_BAR;
        PG8_WAIT_V(2); PG8_BAR;
        PG8_STAGE(PG8_SB(1, 0), cB + kstep, voffB); PG8_STAGE(PG8_SA(1, 0), cA + kstep, voffA); PG8_STAGE(PG8_SB(1, 1), cB + hstep + kstep, voffB);
        PG8_WAIT_V(6); PG8_BAR;
    } else {
        PG8_STAGE(PG8_SB(0, 0), cB, voffB); PG8_STAGE(PG8_SA(0, 0), cA, voffA); PG8_STAGE(PG8_SB(0, 1), cB + hstep, voffB); PG8_STAGE(PG8_SA(0, 1), cA + hstep, voffA);
        if (wr == 1) PG8_BAR;
        PG8_WAIT_V(4); PG8_BAR;
        PG8_STAGE(PG8_SB(1, 0), cB + kstep, voffB); PG8_STAGE(PG8_SA(1, 0), cA + kstep, voffA); PG8_STAGE(PG8_SB(1, 1), cB + hstep + kstep, voffB);
        PG8_WAIT_V(6); PG8_BAR;
    }
    for (;;) {
        const bool has_next = S.next(ui + 1, nxt);
        const char* nA = has_next ? (const char*)g.A + (size_t)nxt.pm * tstep : cA; const char* nB = has_next ? (const char*)g.Bt + (size_t)nxt.pn * tstep : cB;
        for (int t = 0; t < nt; t += 2) {
            const bool last = (t == nt - 2);
            const char* a1 = cA + (size_t)(t + 1) * kstep;
            const char* a2 = last ? nA : cA + (size_t)(t + 2) * kstep; const char* b2 = last ? nB : cB + (size_t)(t + 2) * kstep;
            const char* a3 = a2 + kstep; const char* b3 = b2 + kstep;
            if (last && has_next) S.a_ready(nxt);
            if constexpr (SP2) {
            PG8_LDB(B0, 0, 0); PG8_LDB(B1, 0, 1); PG8_SCHED; PG8_LDA(At, 0, 0); PG8_STAGE(PG8_SA(1, 1), a1 + hstep, voffA);
            PG8_WAIT_V(8); PG8_WAIT_L(0); PG8_BAR; PG8_MMA(0, 0, At, B0); PG8_MMA(0, 1, At, B1); PG8_BAR; PG8_SCHED;
            PG8_LDA(At, 0, 1); PG8_STAGE(PG8_SB(0, 0), b2, voffB); PG8_STAGE(PG8_SB(0, 1), b2 + hstep, voffB); PG8_STAGE(PG8_SA(0, 0), a2, voffA);
            PG8_WAIT_V(8); PG8_WAIT_L(0); PG8_BAR; PG8_MMA(1, 0, At, B0); PG8_MMA(1, 1, At, B1); PG8_BAR; PG8_SCHED;
            PG8_LDB(B0, 1, 0); PG8_LDB(B1, 1, 1); PG8_SCHED; PG8_LDA(At, 1, 0); PG8_STAGE(PG8_SA(0, 1), a2 + hstep, voffA);
            PG8_WAIT_V(8); PG8_WAIT_L(0); PG8_BAR; PG8_MMA(0, 0, At, B0); PG8_MMA(0, 1, At, B1); PG8_BAR; PG8_SCHED;
            PG8_LDA(At, 1, 1); PG8_STAGE(PG8_SB(1, 0), b3, voffB); PG8_STAGE(PG8_SB(1, 1), b3 + hstep, voffB); PG8_STAGE(PG8_SA(1, 0), a3, voffA);
            PG8_WAIT_V(8); PG8_WAIT_L(0); PG8_BAR; PG8_MMA(1, 0, At, B0); PG8_MMA(1, 1, At, B1); PG8_BAR; PG8_SCHED;
            } else {
            PG8_LDB(B0, 0, 0); PG8_SCHED; PG8_LDA(At, 0, 0); PG8_STAGE(PG8_SA(1, 1), a1 + hstep, voffA);
            PG8_WAIT_L(8); PG8_BAR; PG8_WAIT_L(0); PG8_MMA(0, 0, At, B0); PG8_BAR; PG8_SCHED;
            PG8_LDB(B1, 0, 1); PG8_STAGE(PG8_SB(0, 0), b2, voffB);
            PG8_BAR; PG8_WAIT_L(0); PG8_MMA(0, 1, At, B1); PG8_BAR;
            PG8_LDA(At, 0, 1); PG8_STAGE(PG8_SA(0, 0), a2, voffA);
            PG8_BAR; PG8_WAIT_L(0); PG8_MMA(1, 0, At, B0); PG8_BAR; PG8_SCHED;
            PG8_STAGE(PG8_SB(0, 1), b2 + hstep, voffB);
            PG8_WAIT_V(6); PG8_BAR; PG8_MMA(1, 1, At, B1); PG8_BAR;
            PG8_LDB(B0, 1, 0); PG8_SCHED; PG8_LDA(At, 1, 0); PG8_STAGE(PG8_SA(0, 1), a2 + hstep, voffA);
            PG8_WAIT_L(8); PG8_BAR; PG8_WAIT_L(0); PG8_MMA(0, 0, At, B0); PG8_BAR; PG8_SCHED;
            PG8_LDB(B1, 1, 1); PG8_STAGE(PG8_SB(1, 0), b3, voffB);
            PG8_BAR; PG8_WAIT_L(0); PG8_MMA(0, 1, At, B1); PG8_BAR;
            PG8_LDA(At, 1, 1); PG8_STAGE(PG8_SA(1, 0), a3, voffA);
            PG8_BAR; PG8_WAIT_L(0); PG8_MMA(1, 0, At, B0); PG8_BAR; PG8_SCHED;
            PG8_STAGE(PG8_SB(1, 1), b3 + hstep, voffB);
            PG8_WAIT_V(6); PG8_BAR; PG8_MMA(1, 1, At, B1); PG8_BAR;
            }
        }
        if constexpr (ALIGN_EPI) { if (wr == 0) PG8_BAR; }
        if constexpr (!Epi::AFTER_DRAIN) { E(acc, cur, wr, wc, fr, fq); S.done(cur); }
        if (!has_next) break;
#pragma unroll
        for (int a = 0; a < 2; ++a)
#pragma unroll
            for (int b = 0; b < 2; ++b)
#pragma unroll
                for (int m = 0; m < 4; ++m)
#pragma unroll
                    for (int n = 0; n < 2; ++n) acc[a][b][m][n] = (f32x4){0.f, 0.f, 0.f, 0.f};
        cur = nxt; cA = nA; cB = nB; ++ui;
        if constexpr (ALIGN_EPI) { if (wr == 1) PG8_BAR; }
    }
    PG8_WAIT_V(0);
    if constexpr (!ALIGN_EPI) { if (wr == 0) PG8_BAR; }
    PG8_BAR;
    if constexpr (Epi::AFTER_DRAIN) { E.fused(acc, cur, wr, wc, fr, fq, lds, wid, lane); S.done(cur); }
#undef PG8_SA
#undef PG8_SB
#undef PG8_STAGE
#undef PG8_LDA
#undef PG8_LDB
#undef PG8_MMA
#undef PG8_WAIT_V
#undef PG8_WAIT_L
#undef PG8_BAR
#undef PG8_SCHED
}
}

constexpr int NB = 8, S = 8192, D = 1024, FF = 2816, PW = 3072, M = NB * S, DEPTH = 4;
constexpr int NWAVES = 8, NTHR = 512;
#define LAS __attribute__((address_space(3)))
typedef unsigned short bf16;
typedef float f32x4 __attribute__((ext_vector_type(4)));
typedef float f32x2 __attribute__((ext_vector_type(2)));
typedef unsigned u32x4 __attribute__((ext_vector_type(4)));
typedef unsigned u32x2 __attribute__((ext_vector_type(2)));

__device__ __forceinline__ int ltid() { int t = threadIdx.x; asm volatile("" : "+v"(t)); return t; }
namespace at {
typedef short bf16x8 __attribute__((ext_vector_type(8)));
typedef short s16x4 __attribute__((ext_vector_type(4)));
typedef float f32x16 __attribute__((ext_vector_type(16)));
constexpr int KROW = 144, KBUF = 64 * KROW, VBUF = 16384, ATT_LDS = 2 * KBUF + 2 * VBUF;
constexpr float NEGF = -1e30f;
__device__ __forceinline__ unsigned cvtpk(float lo, float hi) { typedef __bf16 b2 __attribute__((ext_vector_type(2))); f32x2 v = {lo, hi}; b2 b = __builtin_convertvector(v, b2); return __builtin_bit_cast(unsigned, b); }
__device__ __forceinline__ float max3f(float a, float b, float c) { float r; asm("v_max3_f32 %0, %1, %2, %3" : "=v"(r) : "v"(a), "v"(b), "v"(c)); return r; }
__device__ __forceinline__ float partner_max(float v) { auto rr = __builtin_amdgcn_permlane32_swap(__float_as_uint(v), __float_as_uint(v), false, false); return fmaxf(__uint_as_float(rr[0]), __uint_as_float(rr[1])); }
__device__ __forceinline__ float partner_sum(float v) { auto rr = __builtin_amdgcn_permlane32_swap(__float_as_uint(v), __float_as_uint(v), false, false); return __uint_as_float(rr[0]) + __uint_as_float(rr[1]); }
__device__ __forceinline__ s16x4 vtr(const LAS unsigned char* p) { typedef short v4i16_t __attribute__((ext_vector_type(4))); return __builtin_bit_cast(s16x4, __builtin_amdgcn_ds_read_tr16_b64_v4i16((LAS v4i16_t*)p)); }
__device__ __forceinline__ bf16x8 pack8(const f32x16& p, int b) {
    u32x4 w; w.x = cvtpk(p[b], p[b + 1]); w.y = cvtpk(p[b + 2], p[b + 3]); w.z = cvtpk(p[b + 4], p[b + 5]); w.w = cvtpk(p[b + 6], p[b + 7]); return __builtin_bit_cast(bf16x8, w);
}

template <int DV>
__device__ __forceinline__ void sweep(LAS unsigned char* lds, const bf16* Kb, const bf16* Vb, size_t rstride, int t_lo, int t_hi, int W, int ql, int wq_lo,
                                      const bf16x8 (&qf)[4], f32x16 (&o)[DV / 32], float& m, float& l) {
    constexpr int NV = DV / 64, ND = DV / 32;
    const int tid = ltid(), lane = tid & 63, r32 = lane & 31, hi = lane >> 5;
    const int krow = tid >> 3, kch = tid & 7;
    const bf16* kg = Kb + (size_t)krow * rstride + kch * 8;
    const int kwoff = krow * KROW + kch * 16;
    const int vrow0 = (DV == 64) ? ((tid >> 4) * 2 + ((tid >> 2) & 1)) : ((tid >> 5) * 2 + ((tid >> 2) & 1));
    const int vch = (DV == 64) ? (((tid >> 3) & 1) * 4 + (tid & 3)) : (((tid >> 3) & 3) * 4 + (tid & 3));
    const bf16* vg = Vb + (size_t)vrow0 * rstride + vch * 8;
    int vwoff[NV];
#pragma unroll
    for (int i = 0; i < NV; ++i) { const int vr = vrow0 + 32 * i; vwoff[i] = (vch >> 2) * 4096 + (vr >> 4) * 1024 + (vr & 15) * 64 + (vch & 3) * 16; }
    const size_t tstep = (size_t)64 * rstride;
    u32x4 kregA, vregA[NV], kregB, vregB[NV];
#define AT_LOAD(KR_, VR_, T_) do { KR_ = *(const u32x4*)(kg + (size_t)(T_) * tstep); \
        _Pragma("unroll") for (int i = 0; i < NV; ++i) VR_[i] = *(const u32x4*)(vg + (size_t)(T_) * tstep + (size_t)(32 * i) * rstride); } while (0)
#define AT_WRITE(KR_, VR_) do { *(LAS u32x4*)(kbuf + kwoff) = KR_; \
        _Pragma("unroll") for (int i = 0; i < NV; ++i) *(LAS u32x4*)(vbuf + vwoff[i]) = VR_[i]; } while (0)
    AT_LOAD(kregA, vregA, t_lo);
    if (t_lo + 1 < t_hi) AT_LOAD(kregB, vregB, t_lo + 1);
    const int kroff = r32 * KROW + hi * 16;
    const int vroff = (4 * hi + ((lane & 15) >> 2)) * 64 + ((lane >> 4) & 1) * 32 + (lane & 3) * 8;
    f32x16 negm;
#pragma unroll
    for (int r = 0; r < 16; ++r) negm[r] = -m;
#define AT_TILE() do { \
        const int k0 = t * 64; \
        const bool relevant = (k0 <= wq_lo + 31) && (wq_lo - (k0 + 63) <= W); \
        if (relevant) { \
            bf16x8 kf[8]; \
_Pragma("unroll") \
            for (int d0 = 0; d0 < 4; ++d0) { kf[2 * d0] = *(const LAS bf16x8*)(kbuf + kroff + d0 * 32); kf[2 * d0 + 1] = *(const LAS bf16x8*)(kbuf + kroff + 32 * KROW + d0 * 32); } \
            f32x16 p0, p1; \
            p0 = __builtin_amdgcn_mfma_f32_32x32x16_bf16(kf[0], qf[0], negm, 0, 0, 0); \
            p1 = __builtin_amdgcn_mfma_f32_32x32x16_bf16(kf[1], qf[0], negm, 0, 0, 0); \
_Pragma("unroll") \
            for (int d0 = 1; d0 < 4; ++d0) { \
                p0 = __builtin_amdgcn_mfma_f32_32x32x16_bf16(kf[2 * d0], qf[d0], p0, 0, 0, 0); \
                p1 = __builtin_amdgcn_mfma_f32_32x32x16_bf16(kf[2 * d0 + 1], qf[d0], p1, 0, 0, 0); \
            } \
 \
            s16x4 vlo[2][4], vhh[2][4]; \
_Pragma("unroll") \
            for (int ks = 0; ks < 4; ++ks) { vlo[0][ks] = vtr(vbuf + vroff + ks * 1024); vhh[0][ks] = vtr(vbuf + vroff + ks * 1024 + 512); } \
            __builtin_amdgcn_sched_barrier(0); \
            const bool full = (k0 + 63 <= wq_lo) && (wq_lo + 31 - k0 <= W); \
            if (!full) { \
_Pragma("unroll") \
                for (int r = 0; r < 16; ++r) { \
                    const int kv = k0 + (r & 3) + 8 * (r >> 2) + 4 * hi; \
                    const bool v0 = (kv <= ql) && (ql - kv <= W), v1 = (kv + 32 <= ql) && (ql - kv - 32 <= W); \
                    p0[r] = v0 ? p0[r] : NEGF; p1[r] = v1 ? p1[r] : NEGF; \
                } \
            } \
            asm volatile("s_nop 15\n\ts_nop 7" : "+v"(p0), "+v"(p1)); \
            float rm; \
            { float a = max3f(p0[0], p0[1], p1[0]), b = max3f(p0[2], p0[3], p1[1]); a = max3f(a, p1[2], p1[3]); \
_Pragma("unroll") \
              for (int r = 4; r < 16; r += 4) { a = max3f(a, p0[r], p0[r + 1]); b = max3f(b, p0[r + 2], p0[r + 3]); a = max3f(a, p1[r], p1[r + 1]); b = max3f(b, p1[r + 2], p1[r + 3]); } \
              rm = fmaxf(a, b); } \
            rm = partner_max(rm); \
            if (__builtin_expect(__any(rm > 8.0f), 0)) { \
                const float dl = fmaxf(rm, 0.f); \
                m += dl; \
_Pragma("unroll") \
                for (int r = 0; r < 16; ++r) { p0[r] -= dl; p1[r] -= dl; negm[r] = -m; } \
                const float f = __builtin_amdgcn_exp2f(-dl); \
                l *= f; \
_Pragma("unroll") \
                for (int d = 0; d < ND; ++d) o[d] = o[d] * f; \
            } \
            float s0 = 0.f, s1 = 0.f; \
_Pragma("unroll") \
            for (int r = 0; r < 16; ++r) { p0[r] = __builtin_amdgcn_exp2f(p0[r]); p1[r] = __builtin_amdgcn_exp2f(p1[r]); s0 += p0[r]; asm volatile("" : "+v"(s0)); s1 += p1[r]; asm volatile("" : "+v"(s1)); } \
            l += s0 + s1; \
            bf16x8 pa[4]; \
            pa[0] = pack8(p0, 0); pa[1] = pack8(p0, 8); pa[2] = pack8(p1, 0); pa[3] = pack8(p1, 8); \
_Pragma("unroll") \
            for (int d = 0; d < ND; ++d) { \
                if (d + 1 < ND) { \
_Pragma("unroll") \
                    for (int ks = 0; ks < 4; ++ks) { vlo[(d + 1) & 1][ks] = vtr(vbuf + vroff + (d + 1) * 4096 + ks * 1024); vhh[(d + 1) & 1][ks] = vtr(vbuf + vroff + (d + 1) * 4096 + ks * 1024 + 512); } \
                } \
_Pragma("unroll") \
                for (int ks = 0; ks < 4; ++ks) { \
                    const s16x4 lo = vlo[d & 1][ks], hh = vhh[d & 1][ks]; \
                    const bf16x8 vf = (bf16x8){lo[0], lo[1], lo[2], lo[3], hh[0], hh[1], hh[2], hh[3]}; \
                    o[d] = __builtin_amdgcn_mfma_f32_32x32x16_bf16(vf, pa[ks], o[d], 0, 0, 0); \
                } \
                if (d + 1 < ND) __builtin_amdgcn_sched_barrier(0); \
            } \
        } \
    } while (0)

    for (int tt = t_lo, st = 0; tt < t_hi; tt += 2, ++st) {
        LAS unsigned char* kb0 = lds + (st & 1) * 2 * KBUF;
        LAS unsigned char* vb0 = lds + 4 * KBUF + (st & 1) * 2 * VBUF;
        { LAS unsigned char* kbuf = kb0; LAS unsigned char* vbuf = vb0; AT_WRITE(kregA, vregA); }
        { LAS unsigned char* kbuf = kb0 + KBUF; LAS unsigned char* vbuf = vb0 + VBUF; AT_WRITE(kregB, vregB); }
        __syncthreads();
        if (tt + 2 < t_hi) { AT_LOAD(kregA, vregA, tt + 2); AT_LOAD(kregB, vregB, tt + 3); }
        { LAS unsigned char* kbuf = kb0; LAS unsigned char* vbuf = vb0; const int t = tt; AT_TILE(); }
        { LAS unsigned char* kbuf = kb0 + KBUF; LAS unsigned char* vbuf = vb0 + VBUF; const int t = tt + 1; AT_TILE(); }
    }
#undef AT_LOAD
#undef AT_WRITE
    __syncthreads();
}

__device__ __forceinline__ void diff_unit(LAS unsigned char* lds, const bf16* proj, bf16* merged, float* stash, float lam, int b, int h, int qb, int blk) {
    const int tid = ltid(), lane = tid & 63, r32 = lane & 31, hi = lane >> 5;
    const int wid = __builtin_amdgcn_readfirstlane(tid >> 6);
    const size_t rowbase = (size_t)b * S;
    const int wq_lo = qb * 256 + wid * 32, ql = wq_lo + r32;
    const bf16* qrow = proj + (rowbase + ql) * PW + h * 128;
    const bf16* kb = proj + rowbase * PW + 512 + h * 128;
    const bf16* vb = proj + rowbase * PW + 1024 + h * 128;
    float* st = stash + ((size_t)blk * NTHR + tid) * 64;
    f32x16 o[4]; float inv = 0.f;
#pragma unroll 1
    for (int comp = 0; comp < 2; ++comp) {
        bf16x8 qf[4];
#pragma unroll
        for (int d0 = 0; d0 < 4; ++d0) qf[d0] = *(const bf16x8*)(qrow + comp * 64 + 16 * d0 + 8 * hi);
#pragma unroll
        for (int d = 0; d < 4; ++d) o[d] = (f32x16){};
        float m = 0.f, l = 0.f;
        sweep<128>(lds, kb + comp * 64, vb, (size_t)PW, 0, 4 * qb + 4, 1 << 30, ql, wq_lo, qf, o, m, l);
        l = partner_sum(l);
        inv = 1.0f / l;
        if (comp == 0) {
#pragma unroll
            for (int d = 0; d < 4; ++d)
#pragma unroll
                for (int r4 = 0; r4 < 4; ++r4)
                    *(f32x4*)(st + d * 16 + r4 * 4) = (f32x4){o[d][4 * r4] * inv, o[d][4 * r4 + 1] * inv, o[d][4 * r4 + 2] * inv, o[d][4 * r4 + 3] * inv};
        }
    }
    float ss = 0.f;
    const float li = lam * inv;
#pragma unroll
    for (int d = 0; d < 4; ++d)
#pragma unroll
        for (int r4 = 0; r4 < 4; ++r4) {
            const f32x4 s1 = *(const f32x4*)(st + d * 16 + r4 * 4);
#pragma unroll
            for (int i = 0; i < 4; ++i) { const float v = s1[i] - li * o[d][4 * r4 + i]; o[d][4 * r4 + i] = v; ss += v * v; }
        }
    ss = partner_sum(ss);
    const float rs = __builtin_amdgcn_rsqf(ss * (1.0f / 128.0f) + 1e-5f);
    bf16* orow = merged + (rowbase + ql) * D + h * 128 + 4 * hi;
#pragma unroll
    for (int d = 0; d < 4; ++d)
#pragma unroll
        for (int r4 = 0; r4 < 4; ++r4) {
            u32x2 w; w.x = cvtpk(o[d][4 * r4] * rs, o[d][4 * r4 + 1] * rs); w.y = cvtpk(o[d][4 * r4 + 2] * rs, o[d][4 * r4 + 3] * rs);
            *(u32x2*)(orow + 32 * d + 8 * r4) = w;
        }
}

__device__ __forceinline__ void dil_unit(LAS unsigned char* lds, const bf16* proj, bf16* part, f32x2* ml, int b, int head, int dil, int res, int lblk) {
    const int tid = ltid(), lane = tid & 63, r32 = lane & 31, hi = lane >> 5;
    const int wid = __builtin_amdgcn_readfirstlane(tid >> 6);
    const int wq_lo = lblk * 256 + wid * 32, ql = wq_lo + r32;
    const size_t row = (size_t)b * S + (size_t)ql * dil + res;
    const bf16* qrow = proj + row * PW + 1536 + head * 64;
    const bf16* kb = proj + ((size_t)b * S + res) * PW + 2048 + head * 64;
    const bf16* vb = proj + ((size_t)b * S + res) * PW + 2560 + head * 64;
    bf16x8 qf[4];
#pragma unroll
    for (int d0 = 0; d0 < 4; ++d0) qf[d0] = *(const bf16x8*)(qrow + 16 * d0 + 8 * hi);
    f32x16 o[2]; o[0] = (f32x16){}; o[1] = (f32x16){};
    float m = 0.f, l = 0.f;
    const int t_lo = (4 * lblk - 2) > 0 ? (4 * lblk - 2) : 0;
    sweep<64>(lds, kb, vb, (size_t)dil * PW, t_lo, 4 * lblk + 4, 128, ql, wq_lo, qf, o, m, l);
    l = partner_sum(l);
    const float inv = 1.0f / l;
    bf16* orow = part + row * 512 + head * 64 + 4 * hi;
#pragma unroll
    for (int d = 0; d < 2; ++d)
#pragma unroll
        for (int r4 = 0; r4 < 4; ++r4) {
            u32x2 w; w.x = cvtpk(o[d][4 * r4] * inv, o[d][4 * r4 + 1] * inv); w.y = cvtpk(o[d][4 * r4 + 2] * inv, o[d][4 * r4 + 3] * inv);
            *(u32x2*)(orow + 32 * d + 8 * r4) = w;
        }
    if (hi == 0) ml[row * 8 + head] = (f32x2){m, l};
}

__device__ __forceinline__ void dil_stream(LAS unsigned char* lds, const bf16* proj, bf16* part_base, f32x2* ml_base, int u0, int ustep, int utotal) {
    constexpr int ND = 2, W = 128, VB = 8192, VOFF = 6 * KBUF;
    const int tid = ltid(), lane = tid & 63, r32 = lane & 31, hi = lane >> 5;
    const int wid = __builtin_amdgcn_readfirstlane(tid >> 6);
    const int krow = tid >> 3, kch = tid & 7;
    const int kwoff = krow * KROW + kch * 16;
    const int vrow0 = (tid >> 4) * 2 + ((tid >> 2) & 1), vch = ((tid >> 3) & 1) * 4 + (tid & 3);
    const int vwoff = (vch >> 2) * 4096 + (vrow0 >> 4) * 1024 + (vrow0 & 15) * 64 + (vch & 3) * 16;
    const int kroff = r32 * KROW + hi * 16;
    const int vroff = (4 * hi + ((lane & 15) >> 2)) * 64 + ((lane >> 4) & 1) * 32 + (lane & 3) * 8;
    u32x4 kst[6], vst[6]; bf16x8 qn[4];
    int u = u0; if (u >= utotal) return;
    int cb, chead, cdil, cres, clblk, cbr;
#define DS_DECODE(U_) do { cbr = (U_) >> 11; const int rem_ = (U_) & 2047, bhd_ = rem_ >> 5, blk_ = rem_ & 31; const int sh_ = (cbr == 0) ? 5 : (cbr == 1 ? 3 : 1); \
        cdil = (cbr == 0) ? 1 : (cbr == 1 ? 4 : 16); cb = bhd_ >> 3; chead = bhd_ & 7; cres = blk_ >> sh_; clblk = blk_ & ((1 << sh_) - 1); } while (0)
#define DS_LOAD() do { const int tl_ = (4 * clblk - 2) > 0 ? (4 * clblk - 2) : 0, nt_ = 4 * clblk + 4 - tl_; \
        const bf16* base_ = proj + ((size_t)cb * S + cres) * PW + chead * 64; const size_t rs_ = (size_t)cdil * PW; \
        _Pragma("unroll") for (int j = 0; j < 6; ++j) if (j < nt_) { \
            kst[j] = *(const u32x4*)(base_ + 2048 + (size_t)((tl_ + j) * 64 + krow) * rs_ + kch * 8); \
            vst[j] = *(const u32x4*)(base_ + 2560 + (size_t)((tl_ + j) * 64 + vrow0) * rs_ + vch * 8); } \
        const bf16* q_ = proj + ((size_t)cb * S + (size_t)(clblk * 256 + wid * 32 + r32) * cdil + cres) * PW + 1536 + chead * 64 + 8 * hi; \
        _Pragma("unroll") for (int d0 = 0; d0 < 4; ++d0) qn[d0] = *(const bf16x8*)(q_ + 16 * d0); } while (0)
    DS_DECODE(u);
    DS_LOAD();
    for (;;) {
        const int t_lo = (4 * clblk - 2) > 0 ? (4 * clblk - 2) : 0, ntu = 4 * clblk + 4 - t_lo;
#pragma unroll
        for (int j = 0; j < 6; ++j) if (j < ntu) { *(LAS u32x4*)(lds + j * KBUF + kwoff) = kst[j]; *(LAS u32x4*)(lds + VOFF + j * VB + vwoff) = vst[j]; }
        bf16x8 qf[4];
#pragma unroll
        for (int d0 = 0; d0 < 4; ++d0) qf[d0] = qn[d0];
        __syncthreads();
        const int wq_lo = clblk * 256 + wid * 32, ql = wq_lo + r32;
        const size_t row = (size_t)cb * S + (size_t)ql * cdil + cres;
        const int head = chead;
        bf16* part = part_base + (size_t)cbr * M * 512; f32x2* ml = ml_base + (size_t)cbr * M * 8;
        const int un = u + ustep; const bool has_next = un < utotal;
        if (has_next) { DS_DECODE(un); DS_LOAD(); }
        f32x16 o[2]; o[0] = (f32x16){}; o[1] = (f32x16){};
        float m = 0.f, l = 0.f;
        f32x16 negm = (f32x16){};
#pragma unroll 2
        for (int j = 0; j < ntu; ++j) {
            LAS unsigned char* kbuf = lds + j * KBUF;
            LAS unsigned char* vbuf = lds + VOFF + j * VB;
            const int t = t_lo + j;
            AT_TILE();
        }
        l = partner_sum(l);
        const float inv = 1.0f / l;
        bf16* orow = part + row * 512 + head * 64 + 4 * hi;
#pragma unroll
        for (int d = 0; d < 2; ++d)
#pragma unroll
            for (int r4 = 0; r4 < 4; ++r4) {
                u32x2 w; w.x = cvtpk(o[d][4 * r4] * inv, o[d][4 * r4 + 1] * inv); w.y = cvtpk(o[d][4 * r4 + 2] * inv, o[d][4 * r4 + 3] * inv);
                *(u32x2*)(orow + 32 * d + 8 * r4) = w;
            }
        if (hi == 0) ml[row * 8 + head] = (f32x2){m, l};
        __syncthreads();
        if (!has_next) break;
        u = un;
    }
#undef DS_DECODE
#undef DS_LOAD
}
#undef AT_TILE
}

constexpr size_t MiB = (size_t)1 << 20;
constexpr size_t WS_ROPE = 1 * MiB;
constexpr size_t WS_SSP = 3 * MiB;
constexpr size_t WS_W = 8 * MiB;
constexpr size_t W_GU1 = 0, W_D1 = 11 * MiB, W_GU2 = W_D1 + 5 * MiB + 512 * 1024, W_D2 = W_GU2 + 11 * MiB, W_IN = W_D2 + 5 * MiB + 512 * 1024, W_OUT = W_IN + 6 * MiB;
constexpr size_t WS_XB = 64 * MiB;
constexpr size_t WS_PROJ = 192 * MiB;
constexpr size_t WS_MRG = 576 * MiB;
constexpr size_t WS_PART = 704 * MiB;
constexpr size_t WS_ML = 896 * MiB;
constexpr size_t WS_STASH = 908 * MiB;
constexpr size_t WS_W1 = 940 * MiB;
constexpr size_t WS_END = 984 * MiB;
constexpr int LDS_BYTES = 147456;

#define XB_TMO      128
#define XB_XCNT(j)  (256  + 64 * (j))
#define XB_XSUB(j)  (1280 + 64 * (j))
#define XB_XGEN(j)  (2304 + 64 * (j))
#define XB_TOP      3328
#define XB_TOPGEN   3392
#define XCD_BAR_WORDS 3456
#define XB_SPIN_CAP (1u << 18)

__device__ __forceinline__ unsigned xb_ld(unsigned* p)              { return __hip_atomic_load(p, __ATOMIC_RELAXED, __HIP_MEMORY_SCOPE_AGENT); }
__device__ __forceinline__ unsigned xb_add(unsigned* p, unsigned v) { return __hip_atomic_fetch_add(p, v, __ATOMIC_RELAXED, __HIP_MEMORY_SCOPE_AGENT); }
__device__ __forceinline__ unsigned xb_xcc_id() { return (unsigned)__builtin_amdgcn_s_getreg((3 << 11) | 20) & 0xFu; }
#define XB_SPIN(cond, bar) do { unsigned _sp = 0; while (cond) { __builtin_amdgcn_s_sleep(1); \
    if ((++_sp & 255u) == 0u) { if (xb_ld(&(bar)[XB_TMO])) break; if (_sp > XB_SPIN_CAP) { atomicAdd(&(bar)[XB_TMO], 1u); break; } } } } while (0)

struct XcdBarrier {
    unsigned* bar; unsigned x;
    volatile LAS unsigned* st;
};

__device__ __forceinline__ XcdBarrier xcd_barrier_post(unsigned* bar, volatile LAS unsigned* st) {
    XcdBarrier b; b.bar = bar; b.x = xb_xcc_id(); b.st = st;
    if (threadIdx.x == 0) (void)xb_add(&bar[XB_XCNT(b.x)], 1u);
    return b;
}
__device__ __forceinline__ void xcd_barrier_complete(unsigned* bar, unsigned x, unsigned& nloc, unsigned& nx) {
    const unsigned G = gridDim.x * gridDim.y * gridDim.z;
    unsigned sum, cnt, mine, sp = 0u;
    for (;;) {
        sum = 0u; cnt = 0u; mine = 0u;
#pragma unroll
        for (unsigned j = 0; j < 16; ++j) { const unsigned c = xb_ld(&bar[XB_XCNT(j)]); sum += c; cnt += (c > 0u) ? 1u : 0u; mine = (j == x) ? c : mine; }
        if (sum == G) break;
        __builtin_amdgcn_s_sleep(1);
        if ((++sp & 255u) == 0u) { if (xb_ld(&bar[XB_TMO])) break; if (sp > XB_SPIN_CAP) { atomicAdd(&bar[XB_TMO], 1u); break; } }
    }
    nloc = mine > 0u ? mine : 1u; nx = cnt > 0u ? cnt : 1u;
}

__device__ __forceinline__ void xcd_barrier(const XcdBarrier& b) {
    asm volatile("s_waitcnt vmcnt(0)" ::: "memory");
    __syncthreads();
    if (threadIdx.x == 0) {
        unsigned* bar = b.bar;
        __builtin_amdgcn_s_waitcnt(0);
        unsigned nloc = b.st[0], nx = b.st[1];
        if (nloc == 0u) { xcd_barrier_complete(bar, b.x, nloc, nx); b.st[0] = nloc; b.st[1] = nx; }
        const unsigned old = xb_add(&bar[XB_XSUB(b.x)], 1u);
        const unsigned gen = old / nloc;
        if (old + 1u == (gen + 1u) * nloc) {
            __builtin_amdgcn_fence(__ATOMIC_RELEASE, "agent");
            asm volatile("s_waitcnt vmcnt(0)" ::: "memory");
            const unsigned og = xb_add(&bar[XB_TOP], 1u);
            const unsigned tg = og / nx;
            if (og + 1u == (tg + 1u) * nx) xb_add(&bar[XB_TOPGEN], 1u);
            else XB_SPIN(xb_ld(&bar[XB_TOPGEN]) == tg, bar);
            __builtin_amdgcn_fence(__ATOMIC_ACQUIRE, "agent");
            xb_add(&bar[XB_XGEN(b.x)], 1u);
            asm volatile("s_waitcnt vmcnt(0)" ::: "memory");
        } else {
            XB_SPIN(xb_ld(&bar[XB_XGEN(b.x)]) == gen, bar);
            __builtin_amdgcn_fence(__ATOMIC_ACQUIRE, "agent");
            asm volatile("s_waitcnt vmcnt(0)" ::: "memory");
        }
    }
    __syncthreads();
}

constexpr size_t WS_BAR = 0, BAR_ZERO_BYTES = 16384;
constexpr int LDS_MISC = 131072 + 512;
struct Args { const void* in[20]; float* out; unsigned char* ws; float lam_init[4]; int ph_lo, ph_hi; };

__device__ __forceinline__ float wave_sum(float v) {
#pragma unroll
    for (int o = 1; o < 64; o <<= 1) v += __shfl_xor(v, o);
    return v;
}
__device__ __forceinline__ unsigned f2bf(float f) { unsigned u = __builtin_bit_cast(unsigned, f); return (u + 0x7fffu + ((u >> 16) & 1u)) >> 16; }
__device__ __forceinline__ unsigned pk2(float lo, float hi) { return f2bf(lo) | (f2bf(hi) << 16); }
__device__ __forceinline__ float bf2f(unsigned short h) { return __builtin_bit_cast(float, (unsigned)h << 16); }

__device__ __forceinline__ void conv_item(const float* W, int K, int N, bf16* WT, int rmode, int part, int gmode, const float* g0, const float* g1, float gs, LAS float* scr, int item, int lane) {
    const int nblk = N / 32, kb = item / nblk, nb = item % nblk, k0 = 64 * kb, n0 = 32 * nb;
#pragma unroll 8
    for (int i = 0; i < 32; ++i) {
        const int kk = 2 * i + (lane >> 5), k = k0 + kk;
        float g = 1.0f;
        if (gmode == 1) g = g0[k]; else if (gmode == 2) g = (k < 512) ? g0[k & 127] * gs : g1[k - 512];
        scr[kk * 33 + (lane & 31)] = W[(size_t)k * N + n0 + (lane & 31)] * g;
    }
    asm volatile("s_waitcnt lgkmcnt(0)" ::: "memory");
    const int c = lane & 7;
#pragma unroll
    for (int j = 0; j < 4; ++j) {
        const int nl = (lane >> 3) + 8 * j, n = n0 + nl; const LAS float* s = scr + (8 * c) * 33 + nl;
        int rowd = n;
        if (rmode == 1) rowd = ((n >> 7) << 8) + part * 128 + (n & 127);
        else if (rmode == 2) { const int cc = n & 255; rowd = (n & ~255) + ((cc >> 5) & 1) * 128 + (cc >> 6) * 32 + (cc & 31); }
        u32x4 o; o.x = pk2(s[0 * 33], s[1 * 33]); o.y = pk2(s[2 * 33], s[3 * 33]); o.z = pk2(s[4 * 33], s[5 * 33]); o.w = pk2(s[6 * 33], s[7 * 33]);
        *(u32x4*)(WT + (size_t)rowd * K + k0 + 8 * c) = o;
    }
    asm volatile("s_waitcnt lgkmcnt(0)" ::: "memory");
}

typedef const Args __attribute__((address_space(4)))* ArgsP;
__device__ __forceinline__ void convert_layer(ArgsP ap, int l, LAS unsigned char* lds, int gw, int ngw, int wave, int lane) {
    LAS float* scr = (LAS float*)(lds + wave * 16384);
    unsigned char* wb = ap->ws + ((l & 1) ? WS_W1 : WS_W);
    constexpr int I_G = (D / 64) * (FF / 32), I_D = (FF / 64) * (D / 32), I_IN = (D / 64) * (PW / 32), I_OUT = (D / 64) * (D / 32);
    constexpr int NITEMS = 4 * I_G + 2 * I_D + I_IN + I_OUT;
    const size_t wgu = (size_t)D * FF;
    const float* n1 = (const float*)ap->in[2] + l * D; const float* n2 = (const float*)ap->in[15] + l * D; const float* nm = (const float*)ap->in[6] + l * D;
    for (int it = gw; it < NITEMS; it += ngw) {
        int r = it;
        if (r < I_G) { conv_item((const float*)ap->in[3] + l * wgu, D, FF, (bf16*)(wb + W_GU1), 1, 0, 1, n1, nullptr, 1.f, scr, r, lane); continue; } r -= I_G;
        if (r < I_G) { conv_item((const float*)ap->in[4] + l * wgu, D, FF, (bf16*)(wb + W_GU1), 1, 1, 1, n1, nullptr, 1.f, scr, r, lane); continue; } r -= I_G;
        if (r < I_D) { conv_item((const float*)ap->in[5] + l * wgu, FF, D, (bf16*)(wb + W_D1), 0, 0, 0, nullptr, nullptr, 1.f, scr, r, lane); continue; } r -= I_D;
        if (r < I_G) { conv_item((const float*)ap->in[16] + l * wgu, D, FF, (bf16*)(wb + W_GU2), 1, 0, 1, n2, nullptr, 1.f, scr, r, lane); continue; } r -= I_G;
        if (r < I_G) { conv_item((const float*)ap->in[17] + l * wgu, D, FF, (bf16*)(wb + W_GU2), 1, 1, 1, n2, nullptr, 1.f, scr, r, lane); continue; } r -= I_G;
        if (r < I_D) { conv_item((const float*)ap->in[18] + l * wgu, FF, D, (bf16*)(wb + W_D2), 0, 0, 0, nullptr, nullptr, 1.f, scr, r, lane); continue; } r -= I_D;
        if (r < I_IN) { conv_item((const float*)ap->in[7] + (size_t)l * D * PW, D, PW, (bf16*)(wb + W_IN), 2, 0, 1, nm, nullptr, 1.f, scr, r, lane); continue; } r -= I_IN;
        conv_item((const float*)ap->in[14] + (size_t)l * D * D, D, D, (bf16*)(wb + W_OUT), 0, 0, 2, (const float*)ap->in[12] + l * 128, (const float*)ap->in[13] + l * 512, 1.0f - ap->lam_init[l], scr, r, lane);
    }
}

__global__ void __launch_bounds__(NTHR, 2) mega(Args a) {
    extern __shared__ __attribute__((aligned(16))) unsigned char lds_raw[];
    LAS unsigned char* lds = (LAS unsigned char*)lds_raw;
    const int ph_lo = a.ph_lo, ph_hi = a.ph_hi;
    volatile LAS unsigned* bst = (volatile LAS unsigned*)(lds + LDS_MISC);
    if (threadIdx.x < 2) bst[threadIdx.x] = 0u;
    __syncthreads();
    XcdBarrier bar; bar.bar = (unsigned*)(a.ws + WS_BAR); bar.x = 0; bar.st = bst;
    if (ph_hi - ph_lo > 1) bar = xcd_barrier_post((unsigned*)(a.ws + WS_BAR), bst);
    for (int ph = ph_lo; ph < ph_hi; ++ph) {
        const int tid = ltid(), lane = tid & 63, wave = __builtin_amdgcn_readfirstlane(tid >> 6);
        int G = gridDim.x, bx = blockIdx.x; asm volatile("" : "+s"(G), "+s"(bx));
        const int vcu = (G % 8 == 0) ? (bx % 8) * (G / 8) + bx / 8 : bx;
        const int gw = vcu * NWAVES + wave, ngw = G * NWAVES;
        ArgsP ap = (ArgsP)__builtin_amdgcn_kernarg_segment_ptr();
        asm volatile("" : "+s"(ap));
        unsigned char* ws = ap->ws;
        float* X = ap->out;
        bf16* XB = (bf16*)(ws + WS_XB);
        float* ssp = (float*)(ws + WS_SSP);
        float* cs = (float*)(ws + WS_ROPE);
        bf16* PROJ = (bf16*)(ws + WS_PROJ);
        bf16* HB = (bf16*)(ws + WS_PROJ);
        bf16* MRG = (bf16*)(ws + WS_MRG);
        if (ph == 0) {
            const float* xin = (const float*)ap->in[0];
            for (int row = gw; row < M; row += ngw) {
                const f32x4* xr = (const f32x4*)(xin + (size_t)row * D) + lane;
                u32x2* xb = (u32x2*)(XB + (size_t)row * D) + lane;
                float s = 0.f;
#pragma unroll
                for (int j = 0; j < 4; ++j) {
                    const f32x4 v = xr[64 * j]; s += (v[0] * v[0] + v[1] * v[1]) + (v[2] * v[2] + v[3] * v[3]);
                    u32x2 w; w.x = pk2(v[0], v[1]); w.y = pk2(v[2], v[3]); xb[64 * j] = w;
                }
                s = wave_sum(s);
                if (lane < 16) ssp[(size_t)row * 16 + lane] = (lane == 0) ? s : 0.f;
            }
            const int* pos = (const int*)ap->in[1];
            for (int idx = bx * NTHR + tid; idx < S * 32; idx += G * NTHR) {
                const int s_ = idx >> 5, j = idx & 31;
                double inv = 1.0; for (int q = 0; q < j; ++q) inv *= 0.7498942093324559;
                const float invf = (float)inv;
                const float angf = (float)pos[s_] * invf;
                const double ang = (double)angf;
                const double kk = __builtin_rint(ang * 0.15915494309189535);
                const double r = ang - kk * 6.283185307179586;
                const double x2 = r * r;
                double c = 1.0, sn = r, tc = 1.0, ts = r;
#pragma unroll
                for (int k = 1; k <= 14; ++k) { tc *= -x2 / (double)((2 * k - 1) * (2 * k)); c += tc; ts *= -x2 / (double)((2 * k) * (2 * k + 1)); sn += ts; }
                cs[(size_t)s_ * 64 + j] = (float)c; cs[(size_t)s_ * 64 + 32 + j] = (float)sn;
            }
            convert_layer(ap, 0, lds, gw, ngw, wave, lane);
        } else if (ph == 1 + 8 * DEPTH) {
            const float* g = (const float*)ap->in[19];
            for (int row = gw; row < M; row += ngw) {
                const u32x2* xb = (const u32x2*)(XB + (size_t)row * D) + lane;
                f32x4* xo = (f32x4*)(X + (size_t)row * D) + lane;
                f32x4 v[4]; float s = 0.f;
#pragma unroll
                for (int j = 0; j < 4; ++j) { const u32x2 w = xb[64 * j];
                    v[j] = (f32x4){__builtin_bit_cast(float, w.x << 16), __builtin_bit_cast(float, w.x & 0xffff0000u), __builtin_bit_cast(float, w.y << 16), __builtin_bit_cast(float, w.y & 0xffff0000u)};
                    s += (v[j][0] * v[j][0] + v[j][1] * v[j][1]) + (v[j][2] * v[j][2] + v[j][3] * v[j][3]); }
                const float rs = 1.0f / sqrtf(wave_sum(s) * (1.0f / D) + 1e-6f);
#pragma unroll
                for (int j = 0; j < 4; ++j) { const f32x4 gg = ((const f32x4*)g)[lane + 64 * j]; xo[64 * j] = v[j] * rs * gg; }
            }
        } else {
            const int l = (ph - 1) / 8, k = (ph - 1) % 8;
            unsigned char* wb = ws + ((l & 1) ? WS_W1 : WS_W);
            if (k == 0 || k == 6) {
                pg8::Gemm g{XB, (const bf16*)(wb + (k == 0 ? W_GU1 : W_GU2)), M, 2 * FF, D};
                pg8::StaticOrder SO; SO.init(M, 2 * FF, G, bx);
                pg8::EpiGU E{HB, ssp, FF};
#ifndef SK_GU
                for (int rep_ = 0; rep_ < REP_GU; ++rep_)
                pg8::gemm_phase<pg8::EpiGU, pg8::StaticOrder, true, true>(lds, g, SO, E);
#endif
            } else if (k == 1 || k == 7 || k == 5) {
                pg8::Gemm g{k == 5 ? MRG : HB, (const bf16*)(wb + (k == 1 ? W_D1 : (k == 7 ? W_D2 : W_OUT))), M, D, k == 5 ? D : FF};
                pg8::StaticOrder SO; SO.init(M, D, G, bx);
#ifndef SK_RES
                for (int rep_ = 0; rep_ < REP_RES; ++rep_) {
                pg8::EpiRes E{XB, ssp, rep_ + 1 < REP_RES ? 0.0f : (k == 5 ? 1.0f : 0.5f)};
                pg8::gemm_phase<pg8::EpiRes, pg8::StaticOrder, true, true>(lds, g, SO, E);
                }
#endif
            } else if (k == 2) {
                pg8::Gemm g{XB, (const bf16*)(wb + W_IN), M, PW, D};
                pg8::StaticOrder SO; SO.init(M, PW, G, bx);
                pg8::EpiProj E{PROJ, ssp, cs};
#ifndef SK_PROJ
                for (int rep_ = 0; rep_ < REP_PROJ; ++rep_)
                pg8::gemm_phase<pg8::EpiProj, pg8::StaticOrder, true, true>(lds, g, SO, E);
#endif
            } else if (k == 3) {
                float s1 = ((const float*)ap->in[8])[l * 64 + lane] * ((const float*)ap->in[9])[l * 64 + lane];
                float s2 = ((const float*)ap->in[10])[l * 64 + lane] * ((const float*)ap->in[11])[l * 64 + lane];
                s1 = wave_sum(s1); s2 = wave_sum(s2);
                const float lam = expf(s1) - expf(s2) + ap->lam_init[l];
                float* stash = (float*)(ws + WS_STASH);
              for (int rep_ = 0; rep_ < REP_DIFF; ++rep_)
                for (int r = 0; r < 4; ++r) {
                    const int per = G >> 3, xcd = vcu / per, i = vcu % per;
                    const int bh = (xcd * 4 + r) & 31, qb = ((r & 1) ? 31 - i : i) & 31;
#ifndef SK_DIFF
                    if (per == 32 && (G & 7) == 0) at::diff_unit(lds, PROJ, MRG, stash, lam, bh >> 2, bh & 3, qb, bx);
#endif
                }
              if ((G >> 3) != 32 || (G & 7))
                for (int pi = vcu; pi < 512; pi += G)
#pragma unroll 1
                    for (int i = 0; i < 2; ++i) { const int bh = pi >> 4, s_ = pi & 15, qb = i ? 31 - s_ : s_; at::diff_unit(lds, PROJ, MRG, stash, lam, bh >> 2, bh & 3, qb, bx); }
              for (int rep_ = 0; rep_ < REP_DIL; ++rep_)
                at::dil_stream(lds, PROJ, (bf16*)(ws + WS_PART), (f32x2*)(ws + WS_ML), vcu, G, 6144);
                for (int rep_ = 0; rep_ < REP_MISC; ++rep_)
                if (l + 1 < DEPTH) convert_layer(ap, l + 1, lds, gw, ngw, wave, lane);
            } else if (k == 4) {
                const bf16* part = (const bf16*)(ws + WS_PART); const f32x2* ml = (const f32x2*)(ws + WS_ML);
                for (int rep_ = 0; rep_ < REP_MISC; ++rep_)
                for (int row = gw; row < M; row += ngw) {
                    u32x4 pv[3]; f32x2 mv[3];
#pragma unroll
                    for (int b = 0; b < 3; ++b) { pv[b] = *(const u32x4*)(part + ((size_t)b * M + row) * 512 + 8 * lane); mv[b] = ml[((size_t)b * M + row) * 8 + (lane >> 3)]; }
                    const float mall = fmaxf(mv[0].x, fmaxf(mv[1].x, mv[2].x));
                    float w[3], wsum = 0.f;
#pragma unroll
                    for (int b = 0; b < 3; ++b) { w[b] = mv[b].y * __builtin_amdgcn_exp2f(mv[b].x - mall); wsum += w[b]; }
                    const float iw = 1.0f / wsum;
                    float o[8]; float ss = 0.f;
#pragma unroll
                    for (int i = 0; i < 8; ++i) {
                        float acc = 0.f;
#pragma unroll
                        for (int b = 0; b < 3; ++b) { const unsigned wd = pv[b][i >> 1]; acc += w[b] * bf2f((unsigned short)((i & 1) ? (wd >> 16) : (wd & 0xffffu))); }
                        o[i] = acc * iw; ss += o[i] * o[i];
                    }
                    const float rs = __builtin_amdgcn_rsqf(wave_sum(ss) * (1.0f / 512.0f) + 1e-6f);
                    u32x4 wv; wv.x = pk2(o[0] * rs, o[1] * rs); wv.y = pk2(o[2] * rs, o[3] * rs); wv.z = pk2(o[4] * rs, o[5] * rs); wv.w = pk2(o[6] * rs, o[7] * rs);
                    *(u32x4*)(MRG + (size_t)row * D + 512 + 8 * lane) = wv;
                }
            }
        }
        if (ph + 1 < ph_hi) {
            for (int rep_ = 0; rep_ < REP_SYNC; ++rep_) { if (ph == ph_lo) cg::this_grid().sync(); else xcd_barrier(bar); }
        }
    }
}

extern "C" void kernel_launch(void* const* d_in, const int* in_sizes, int n_in, void* d_out, int out_size, void* d_ws, size_t ws_size, hipStream_t stream) {
    static int grid = 0;
    if (grid == 0) {
        if (n_in != 20 || out_size != M * D || ws_size < WS_END) { fprintf(stderr, "kernel_launch: unexpected problem (n_in %d, out %d, ws %zu)\n", n_in, out_size, ws_size); grid = -1; return; }
        int dev = 0, cus = 0, per_cu = 0;
        hipGetDevice(&dev);
        hipDeviceGetAttribute(&cus, hipDeviceAttributeMultiprocessorCount, dev);
        if (hipFuncSetAttribute((const void*)mega, hipFuncAttributeMaxDynamicSharedMemorySize, LDS_BYTES) != hipSuccess) { fprintf(stderr, "kernel_launch: hipFuncSetAttribute failed\n"); grid = -1; return; }
        if (hipOccupancyMaxActiveBlocksPerMultiprocessor(&per_cu, (const void*)mega, NTHR, LDS_BYTES) != hipSuccess || per_cu < 1) { fprintf(stderr, "kernel_launch: occupancy query says %d\n", per_cu); per_cu = 1; (void)hipGetLastError(); }
        grid = cus * per_cu;
    }
    if (grid < 0) return;
    Args a{};
    for (int i = 0; i < 20; ++i) a.in[i] = d_in[i];
    a.out = (float*)d_out; a.ws = (unsigned char*)d_ws;
    a.lam_init[0] = 0.2f; a.lam_init[1] = (float)(0.8 - 0.6 * 0.7408182206817179); a.lam_init[2] = (float)(0.8 - 0.6 * 0.5488116360940264); a.lam_init[3] = (float)(0.8 - 0.6 * 0.4065696597405991);
    constexpr int NPH = 2 + 8 * DEPTH;
#if MK_PER_PHASE
    for (int ph = 0; ph < NPH; ++ph) {
        a.ph_lo = ph; a.ph_hi = ph + 1;
        hipLaunchKernelGGL(mega, dim3(grid), dim3(NTHR), LDS_BYTES, stream, a);
    }
#else
    a.ph_lo = 0; a.ph_hi = NPH;
    if (hipMemsetAsync((char*)d_ws + WS_BAR, 0, BAR_ZERO_BYTES, stream) != hipSuccess) { fprintf(stderr, "kernel_launch: hipMemsetAsync failed\n"); return; }
    void* args[] = {&a};
    hipError_t e = hipLaunchCooperativeKernel((const void*)mega, dim3(grid), dim3(NTHR), args, LDS_BYTES, stream);
    if (e != hipSuccess) fprintf(stderr, "kernel_launch: cooperative launch failed: %s (grid %d)\n", hipGetErrorString(e), grid);
#endif
}
```

```cpp
#include <hip/hip_runtime.h>
#include <hip/hip_cooperative_groups.h>
#include <cstdio>
#include <cstdint>
namespace cg = cooperative_groups;
#ifndef MK_PER_PHASE
#define MK_PER_PHASE 0
#endif
#ifndef REP_DIFF
#define REP_DIFF 1
#endif
#ifndef REP_DIL
#define REP_DIL 1
#endif
#ifndef REP_GU
#define REP_GU 1
#endif
#ifndef REP_PROJ
#define REP_PROJ 1
#endif
#ifndef REP_RES
#define REP_RES 1
#endif
#ifndef REP_MISC
#define REP_MISC 1
#endif
#ifndef REP_SYNC
#define REP_SYNC 1
#endif
namespace pg8 {
#define PG8_LAS __attribute__((address_space(3)))
typedef unsigned short bf16_t;
typedef short bf16x8 __attribute__((ext_vector_type(8)));
typedef float f32x4 __attribute__((ext_vector_type(4)));
typedef unsigned u32x4 __attribute__((ext_vector_type(4)));
constexpr int BM = 256, BK = 64, HALF = 128, HTB = HALF * BK * 2  , STAGE_BYTES = 8 * HTB, NXCD = 8, WGM = 4;

__host__ __device__ __forceinline__ int lds_byte(int r, int c) { const int st = (r >> 4) * 2 + (c >> 5), rr = r & 15, cc = c & 31, ob = rr * 64 + cc * 2; return st * 1024 + (ob ^ (((ob >> 9) & 1) << 5)); }
__host__ __device__ __forceinline__ void stage_rc(int b, int& R, int& C) { const int st = b / 1024, sb = b % 1024, swz = sb ^ (((sb >> 9) & 1) << 5); R = (st >> 1) * 16 + swz / 64; C = (st & 1) * 32 + (swz % 64) / 2; }
__host__ __device__ __forceinline__ int perm32(int rho) { const int n = rho >> 4, i = rho & 15; return 8 * (i >> 2) + 4 * n + (i & 3); }

struct Unit { int pm, pn; };
struct Gemm { const bf16_t* A; const bf16_t* Bt; int M, N, K; };

struct StaticOrder {
    int nM, nN, nwg, G, c;
    __host__ __device__ void init(int M, int N, int G_, int c_) { nM = M / BM; nN = N / BM; nwg = nM * nN; G = G_; c = c_; }
    __host__ __device__ bool next(int i, Unit& u) const {
        const long L = (long)i * G + c; if (L >= nwg) return false;
        int wgid = (int)L; { const int q = nwg / NXCD, r = nwg % NXCD, xcd = wgid % NXCD, off = wgid / NXCD; wgid = (xcd < r ? xcd * (q + 1) : r * (q + 1) + (xcd - r) * q) + off; }
        const int nig = WGM * nN, gid = wgid / nig, fm = gid * WGM, gsz = (nM - fm) < WGM ? (nM - fm) : WGM;
        u.pm = fm + ((wgid % nig) % gsz); u.pn = (wgid % nig) / gsz; return true;
    }
    __device__ __forceinline__ void a_ready(const Unit&) const {}
    __device__ __forceinline__ void done(const Unit&) const {}
};
__device__ __forceinline__ unsigned cvt_pk_bf16(float lo, float hi) { unsigned r; asm volatile("v_cvt_pk_bf16_f32 %0, %1, %2" : "=v"(r) : "v"(lo), "v"(hi)); return r; }
typedef float f32x2 __attribute__((ext_vector_type(2)));
typedef unsigned u32x2 __attribute__((ext_vector_type(2)));
constexpr int NSSP = 16;
__device__ __forceinline__ void rows_rstd(float (&rs)[8], const float* ssp, int row0, int fq, float mul) {
    f32x4 v[8];
#pragma unroll
    for (int j = 0; j < 8; ++j) v[j] = ((const f32x4*)(ssp + (size_t)(row0 + (j >> 2) * HALF + (j & 3) * 16) * NSSP))[fq];
#pragma unroll
    for (int j = 0; j < 8; ++j) {
        float t = (v[j][0] + v[j][1]) + (v[j][2] + v[j][3]);
        t += __shfl_xor(t, 16); t += __shfl_xor(t, 32);
        rs[j] = mul * __builtin_amdgcn_rsqf(t * (1.0f / 1024.0f) + 1e-6f);
    }
}
struct EpiGU {
    static constexpr bool PERM = true, AFTER_DRAIN = false;
    bf16_t* H; const float* ssp; int ldh;
    __device__ __forceinline__ void operator()(const f32x4 (&acc)[2][2][4][2], const Unit& u, int wr, int wc, int fr_, int fq_) const {
        int fr = fr_, fq = fq_; asm volatile("" : "+v"(fr), "+v"(fq));
        const int row0 = u.pm * BM + wr * 64 + fr, col0 = u.pn * HALF + wc * 32 + 8 * fq;
        float rsv[8]; rows_rstd(rsv, ssp, row0, fq, 1.0f);
#pragma unroll
        for (int ai = 0; ai < 2; ++ai)
#pragma unroll
            for (int m = 0; m < 4; ++m) {
                const int row = row0 + ai * HALF + m * 16;
                const float rs = rsv[ai * 4 + m], rsn = -1.4426950408889634f * rs, rs2 = rs * rs;
                f32x2 t[4], ab[4];
#pragma unroll
                for (int q = 0; q < 4; ++q) {
                    const f32x2 a2 = (f32x2){acc[ai][0][m][q >> 1][(2 * q) & 3], acc[ai][0][m][q >> 1][(2 * q + 1) & 3]};
                    const f32x2 b2 = (f32x2){acc[ai][1][m][q >> 1][(2 * q) & 3], acc[ai][1][m][q >> 1][(2 * q + 1) & 3]};
                    t[q] = a2 * rsn; ab[q] = (a2 * b2) * rs2;
                }
#pragma unroll
                for (int q = 0; q < 4; ++q) { t[q].x = __builtin_amdgcn_exp2f(t[q].x); t[q].y = __builtin_amdgcn_exp2f(t[q].y); }
#pragma unroll
                for (int q = 0; q < 4; ++q) t[q] = t[q] + 1.0f;
#pragma unroll
                for (int q = 0; q < 4; ++q) { t[q].x = __builtin_amdgcn_rcpf(t[q].x); t[q].y = __builtin_amdgcn_rcpf(t[q].y); }
#pragma unroll
                for (int q = 0; q < 4; ++q) ab[q] = ab[q] * t[q];
                u32x4 w; w.x = cvt_pk_bf16(ab[0].x, ab[0].y); w.y = cvt_pk_bf16(ab[1].x, ab[1].y); w.z = cvt_pk_bf16(ab[2].x, ab[2].y); w.w = cvt_pk_bf16(ab[3].x, ab[3].y);
                __builtin_nontemporal_store(w, (u32x4*)(H + (size_t)row * ldh + col0));
            }
    }
};
struct EpiRes {
    static constexpr bool PERM = true, AFTER_DRAIN = false;
    bf16_t* XB; float* ssp; float scale;
    __device__ __forceinline__ void operator()(const f32x4 (&acc)[2][2][4][2], const Unit& u, int wr, int wc, int fr_, int fq_) const {
        int fr = fr_, fq = fq_; asm volatile("" : "+v"(fr), "+v"(fq));
        const int row0 = u.pm * BM + wr * 64 + fr, col0 = u.pn * BM + wc * 32 + 8 * fq;
#pragma unroll
        for (int ai = 0; ai < 2; ++ai) {
            u32x4 xv[4][2];
#pragma unroll
            for (int m = 0; m < 4; ++m)
#pragma unroll
                for (int bj = 0; bj < 2; ++bj) xv[m][bj] = *(const u32x4*)(XB + (size_t)(row0 + ai * HALF + m * 16) * 1024 + col0 + bj * HALF);
#pragma unroll
            for (int m = 0; m < 4; ++m) {
                const int row = row0 + ai * HALF + m * 16;
                f32x2 ss2 = (f32x2){0.f, 0.f};
#pragma unroll
                for (int bj = 0; bj < 2; ++bj) {
                    f32x2 o2[4];
#pragma unroll
                    for (int q = 0; q < 4; ++q) {
                        const unsigned wd = xv[m][bj][q];
                        const f32x2 x2 = (f32x2){__builtin_bit_cast(float, wd << 16), __builtin_bit_cast(float, wd & 0xffff0000u)};
                        const f32x2 a2 = (f32x2){acc[ai][bj][m][q >> 1][(2 * q) & 3], acc[ai][bj][m][q >> 1][(2 * q + 1) & 3]};
                        o2[q] = x2 + a2 * scale;
                    }
#pragma unroll
                    for (int q = 0; q < 4; ++q) ss2 = ss2 + o2[q] * o2[q];
                    u32x4 w; w.x = cvt_pk_bf16(o2[0].x, o2[0].y); w.y = cvt_pk_bf16(o2[1].x, o2[1].y); w.z = cvt_pk_bf16(o2[2].x, o2[2].y); w.w = cvt_pk_bf16(o2[3].x, o2[3].y);
                    *(u32x4*)(XB + (size_t)row * 1024 + col0 + bj * HALF) = w;
                }
                float ss = ss2.x + ss2.y;
                ss += __shfl_xor(ss, 16); ss += __shfl_xor(ss, 32);
                if (fq == 0) ssp[(size_t)row * NSSP + u.pn * 4 + wc] = ss;
            }
            asm volatile("" ::: "memory");
        }
    }
};
struct EpiProj {
    static constexpr bool PERM = true, AFTER_DRAIN = false;
    bf16_t* P; const float* ssp; const float* cs;
    __device__ __forceinline__ void operator()(const f32x4 (&acc)[2][2][4][2], const Unit& u, int wr, int wc, int fr_, int fq_) const {
        int fr = fr_, fq = fq_; asm volatile("" : "+v"(fr), "+v"(fq));
        const int row0 = u.pm * BM + wr * 64 + fr;
        const int t = u.pn;
        const bool rope = !(t == 4 || t == 5 || t == 10 || t == 11);
        const float qs = (t < 2 || t == 6 || t == 7) ? 0.125f * 1.4426950408889634f : 1.0f;
        const int colL = t * BM + wc * 64 + 8 * fq;
        float rsv[8]; rows_rstd(rsv, ssp, row0, fq, qs);
#pragma unroll
        for (int hb = 0; hb < 4; ++hb) {
            const int ai = hb >> 1;
            f32x4 cv[2][4];
            if (rope) {
#pragma unroll
                for (int mm = 0; mm < 2; ++mm) {
                    const int m = (hb & 1) * 2 + mm;
                    const float* cp = cs + (size_t)((row0 + ai * HALF + m * 16) & 8191) * 64 + 8 * fq;
                    cv[mm][0] = *(const f32x4*)(cp); cv[mm][1] = *(const f32x4*)(cp + 4); cv[mm][2] = *(const f32x4*)(cp + 32); cv[mm][3] = *(const f32x4*)(cp + 36);
                }
            }
#pragma unroll
            for (int mm = 0; mm < 2; ++mm) {
                const int m = (hb & 1) * 2 + mm;
                const int row = row0 + ai * HALF + m * 16;
                const float rs = rsv[ai * 4 + m];
                f32x2 o1[4], o2[4];
                if (rope) {
                    const f32x4 c0 = cv[mm][0], c1 = cv[mm][1], s0 = cv[mm][2], s1 = cv[mm][3];
                    f32x2 C[4], Sn[4];
                    C[0] = (f32x2){c0[0], c0[1]} * rs; C[1] = (f32x2){c0[2], c0[3]} * rs; C[2] = (f32x2){c1[0], c1[1]} * rs; C[3] = (f32x2){c1[2], c1[3]} * rs;
                    Sn[0] = (f32x2){s0[0], s0[1]} * rs; Sn[1] = (f32x2){s0[2], s0[3]} * rs; Sn[2] = (f32x2){s1[0], s1[1]} * rs; Sn[3] = (f32x2){s1[2], s1[3]} * rs;
#pragma unroll
                    for (int q = 0; q < 4; ++q) {
                        const f32x2 a2 = (f32x2){acc[ai][0][m][q >> 1][(2 * q) & 3], acc[ai][0][m][q >> 1][(2 * q + 1) & 3]};
                        const f32x2 b2 = (f32x2){acc[ai][1][m][q >> 1][(2 * q) & 3], acc[ai][1][m][q >> 1][(2 * q + 1) & 3]};
                        o1[q] = a2 * C[q] - b2 * Sn[q]; o2[q] = a2 * Sn[q] + b2 * C[q];
                    }
                } else {
#pragma unroll
                    for (int q = 0; q < 4; ++q) {
                        o1[q] = (f32x2){acc[ai][0][m][q >> 1][(2 * q) & 3], acc[ai][0][m][q >> 1][(2 * q + 1) & 3]} * rs;
                        o2[q] = (f32x2){acc[ai][1][m][q >> 1][(2 * q) & 3], acc[ai][1][m][q >> 1][(2 * q + 1) & 3]} * rs;
                    }
                }
                u32x4 w1, w2;
                w1.x = cvt_pk_bf16(o1[0].x, o1[0].y); w1.y = cvt_pk_bf16(o1[1].x, o1[1].y); w1.z = cvt_pk_bf16(o1[2].x, o1[2].y); w1.w = cvt_pk_bf16(o1[3].x, o1[3].y);
                w2.x = cvt_pk_bf16(o2[0].x, o2[0].y); w2.y = cvt_pk_bf16(o2[1].x, o2[1].y); w2.z = cvt_pk_bf16(o2[2].x, o2[2].y); w2.w = cvt_pk_bf16(o2[3].x, o2[3].y);
                bf16_t* pr = P + (size_t)row * 3072 + colL;
                __builtin_nontemporal_store(w1, (u32x4*)(pr)); __builtin_nontemporal_store(w2, (u32x4*)(pr + 32));
            }
            asm volatile("" ::: "memory");
        }
    }
};
template <class Epi, class Sched, bool ALIGN_EPI = false, bool SP2 = false>
__device__ __forceinline__ void gemm_phase(PG8_LAS unsigned char* lds, const Gemm g, const Sched& S, const Epi& E) {
    int tid_ = threadIdx.x; asm volatile("" : "+v"(tid_));
    const int tid = tid_, wid = __builtin_amdgcn_readfirstlane(tid >> 6), lane = tid & 63, wr = wid >> 2, wc = wid & 3, fr = lane & 15, fq = lane >> 4;
    const int K = g.K, nt = K / BK;
    unsigned voffA[2], voffB[2];
#pragma unroll
    for (int i = 0; i < 2; ++i) { int R, C; stage_rc(tid * 16 + i * 8192, R, C); const int Rb = Epi::PERM ? ((R & ~31) + perm32(R & 31)) : R;
        voffA[i] = (unsigned)(R * K + C) * 2u; voffB[i] = (unsigned)(Rb * K + C) * 2u; }
    const size_t kstep = (size_t)(BK * 2);
    const size_t hstep = (size_t)HALF * K * 2;
    const size_t tstep = 2 * hstep;
    const unsigned ldsw = (unsigned)wid * 1024u;
    const int aoff = lds_byte(wr * 64 + fr, fq * 8), boff = lds_byte(wc * 32 + fr, fq * 8);
#define PG8_SA(b, h) (((b) * 2 + (h)) * HTB)
#define PG8_SB(b, h) ((4 + (b) * 2 + (h)) * HTB)
#define PG8_STAGE(bufoff, gbase, voff) do { _Pragma("unroll") for (int _i = 0; _i < 2; ++_i) \
        __builtin_amdgcn_global_load_lds((const unsigned*)((const char*)(gbase) + (voff)[_i]), (PG8_LAS unsigned*)(lds + (bufoff) + ldsw + _i * 8192), 16, 0, 0); } while (0)
#define PG8_LDA(dst, b, h) do { _Pragma("unroll") for (int m = 0; m < 4; ++m) _Pragma("unroll") for (int k = 0; k < 2; ++k) dst[m][k] = *(const PG8_LAS bf16x8*)(lds + PG8_SA(b, h) + aoff + m * 2048 + k * 1024); } while (0)
#define PG8_LDB(dst, b, h) do { _Pragma("unroll") for (int n = 0; n < 2; ++n) _Pragma("unroll") for (int k = 0; k < 2; ++k) dst[n][k] = *(const PG8_LAS bf16x8*)(lds + PG8_SB(b, h) + boff + n * 2048 + k * 1024); } while (0)
#define PG8_MMA(ai, bj, At, Bt) do { __builtin_amdgcn_s_setprio(1); _Pragma("unroll") for (int m = 0; m < 4; ++m) _Pragma("unroll") for (int n = 0; n < 2; ++n) _Pragma("unroll") for (int k = 0; k < 2; ++k) \
        acc[ai][bj][m][n] = __builtin_amdgcn_mfma_f32_16x16x32_bf16(Bt[n][k], At[m][k], acc[ai][bj][m][n], 0, 0, 0); __builtin_amdgcn_s_setprio(0); } while (0)
#define PG8_WAIT_V(n) asm volatile("s_waitcnt vmcnt(" #n ")" ::: "memory")
#define PG8_WAIT_L(n) asm volatile("s_waitcnt lgkmcnt(" #n ")" ::: "memory")
#define PG8_BAR __builtin_amdgcn_s_barrier()
#define PG8_SCHED __builtin_amdgcn_sched_barrier(0)
    Unit cur, nxt; int ui = 0;
    if (!S.next(0, cur)) return;
    f32x4 acc[2][2][4][2];
#pragma unroll
    for (int a = 0; a < 2; ++a)
#pragma unroll
        for (int b = 0; b < 2; ++b)
#pragma unroll
            for (int m = 0; m < 4; ++m)
#pragma unroll
                for (int n = 0; n < 2; ++n) acc[a][b][m][n] = (f32x4){0.f, 0.f, 0.f, 0.f};
    bf16x8 At[4][2], B0[2][2], B1[2][2];
    const char* cA = (const char*)g.A + (size_t)cur.pm * tstep; const char* cB = (const char*)g.Bt + (size_t)cur.pn * tstep;
    S.a_ready(cur);
    if constexpr (SP2) {
        PG8_STAGE(PG8_SB(0, 0), cB, voffB); PG8_STAGE(PG8_SB(0, 1), cB + hstep, voffB); PG8_STAGE(PG8_SA(0, 0), cA, voffA); PG8_STAGE(PG8_SA(0, 1), cA + hstep, voffA);
        if (wr == 1) PG8_BAR;
        PG8_WAIT_V(2); PG8_BAR;
        PG8_STAGE(PG8_SB(1, 0), cB + kstep, voffB); PG8_STAGE(PG8_SA(1, 0), cA + kstep, voffA); PG8_STAGE(PG8_SB(1, 1), cB + hstep + kstep, voffB);
        PG8_WAIT_V(6); PG8_BAR;
    } else {
        PG8_STAGE(PG8_SB(0, 0), cB, voffB); PG8_STAGE(PG8_SA(0, 0), cA, voffA); PG8_STAGE(PG8_SB(0, 1), cB + hstep, voffB); PG8_STAGE(PG8_SA(0, 1), cA + hstep, voffA);
        if (wr == 1) PG8_BAR;
        PG8_WAIT_V(4); PG8_BAR;
        PG8_STAGE(PG8_SB(1, 0), cB + kstep, voffB); PG8_STAGE(PG8_SA(1, 0), cA + kstep, voffA); PG8_STAGE(PG8_SB(1, 1), cB + hstep + kstep, voffB);
        PG8_WAIT_V(6); PG8_BAR;
    }
    for (;;) {
        const bool has_next = S.next(ui + 1, nxt);
        const char* nA = has_next ? (const char*)g.A + (size_t)nxt.pm * tstep : cA; const char* nB = has_next ? (const char*)g.Bt + (size_t)nxt.pn * tstep : cB;
        for (int t = 0; t < nt; t += 2) {
            const bool last = (t == nt - 2);
            const char* a1 = cA + (size_t)(t + 1) * kstep;
            const char* a2 = last ? nA : cA + (size_t)(t + 2) * kstep; const char* b2 = last ? nB : cB + (size_t)(t + 2) * kstep;
            const char* a3 = a2 + kstep; const char* b3 = b2 + kstep;
            if (last && has_next) S.a_ready(nxt);
            if constexpr (SP2) {
            PG8_LDB(B0, 0, 0); PG8_LDB(B1, 0, 1); PG8_SCHED; PG8_LDA(At, 0, 0); PG8_STAGE(PG8_SA(1, 1), a1 + hstep, voffA);
            PG8_WAIT_V(8); PG8_WAIT_L(0); PG8_BAR; PG8_MMA(0, 0, At, B0); PG8_MMA(0, 1, At, B1); PG8_BAR; PG8_SCHED;
            PG8_LDA(At, 0, 1); PG8_STAGE(PG8_SB(0, 0), b2, voffB); PG8_STAGE(PG8_SB(0, 1), b2 + hstep, voffB); PG8_STAGE(PG8_SA(0, 0), a2, voffA);
            PG8_WAIT_V(8); PG8_WAIT_L(0); PG8_BAR; PG8_MMA(1, 0, At, B0); PG8_MMA(1, 1, At, B1); PG8_BAR; PG8_SCHED;
            PG8_LDB(B0, 1, 0); PG8_LDB(B1, 1, 1); PG8_SCHED; PG8_LDA(At, 1, 0); PG8_STAGE(PG8_SA(0, 1), a2 + hstep, voffA);
            PG8_WAIT_V(8); PG8_WAIT_L(0); PG8_BAR; PG8_MMA(0, 0, At, B0); PG8_MMA(0, 1, At, B1); PG8_BAR; PG8_SCHED;
            PG8_LDA(At, 1, 1); PG8_STAGE(PG8_SB(1, 0), b3, voffB); PG8_STAGE(PG8_SB(1, 1), b3 + hstep, voffB); PG8_STAGE(PG8_SA(1, 0), a3, voffA);
            PG8_WAIT_V(8); PG8_WAIT_L(0); PG8_BAR; PG8_MMA(1, 0, At, B0); PG8_MMA(1, 1, At, B1); PG8_BAR; PG8_SCHED;
            } else {
            PG8_LDB(B0, 0, 0); PG8_SCHED; PG8_LDA(At, 0, 0); PG8_STAGE(PG8_SA(1, 1), a1 + hstep, voffA);
            PG8_WAIT_L(8); PG8_BAR; PG8_WAIT_L(0); PG8_MMA(0, 0, At, B0); PG8_BAR; PG8_SCHED;
            PG8_LDB(B1, 0, 1); PG8_STAGE(PG8_SB(0, 0), b2, voffB);
            PG8_BAR; PG8_WAIT_L(0); PG8_MMA(0, 1, At, B1); PG8_BAR;
            PG8_LDA(At, 0, 1); PG8_STAGE(PG8_SA(0, 0), a2, voffA);
            PG8_BAR; PG8_WAIT_L(0); PG8_MMA(1, 0, At, B0); PG8_BAR; PG8_SCHED;
            PG8_STAGE(PG8_SB(0, 1), b2 + hstep, voffB);
            PG8_WAIT_V(6); PG8_BAR; PG8_MMA(1, 1, At, B1); PG8_BAR;
            PG8_LDB(B0, 1, 0); PG8_SCHED; PG8_LDA(At, 1, 0); PG8_STAGE(PG8_SA(0, 1), a2 + hstep, voffA);
            PG8_WAIT_L(8); PG8_BAR; PG8_WAIT_L(0); PG8_MMA(0, 0, At, B0); PG8_BAR; PG8_SCHED;
            PG8_LDB(B1, 1, 1); PG8_STAGE(PG8_SB(1, 0), b3, voffB);
            PG8_BAR; PG8_WAIT_L(0); PG8_MMA(0, 1, At, B1); PG8_BAR;
            PG8_LDA(At, 1, 1); PG8_STAGE(PG8_SA(1, 0), a3, voffA);
            PG8_BAR; PG8_WAIT_L(0); PG8_MMA(1, 0, At, B0); PG8_BAR; PG8_SCHED;
            PG8_STAGE(PG8_SB(1, 1), b3 + hstep, voffB);
            PG8_WAIT_V(6); PG8_BAR; PG8_MMA(1, 1, At, B1); PG8_BAR;
            }
        }
        if constexpr (ALIGN_EPI) { if (wr == 0) PG8_BAR; }
        if constexpr (!Epi::AFTER_DRAIN) { E(acc, cur, wr, wc, fr, fq); S.done(cur); }
        if (!has_next) break;
#pragma unroll
        for (int a = 0; a < 2; ++a)
#pragma unroll
            for (int b = 0; b < 2; ++b)
#pragma unroll
                for (int m = 0; m < 4; ++m)
#pragma unroll
                    for (int n = 0; n < 2; ++n) acc[a][b][m][n] = (f32x4){0.f, 0.f, 0.f, 0.f};
        cur = nxt; cA = nA; cB = nB; ++ui;
        if constexpr (ALIGN_EPI) { if (wr == 1) PG8_BAR; }
    }
    PG8_WAIT_V(0);
    if constexpr (!ALIGN_EPI) { if (wr == 0) PG8_BAR; }
    PG8_BAR;
    if constexpr (Epi::AFTER_DRAIN) { E.fused(acc, cur, wr, wc, fr, fq, lds, wid, lane); S.done(cur); }
#undef PG8_SA
#undef PG8_SB
#undef PG8_STAGE
#undef PG8_LDA
#undef PG8_LDB
#undef PG8_MMA
#undef PG8_WAIT_V
#undef PG8_WAIT_L
#undef PG8_BAR
#undef PG8_SCHED
}
}

constexpr int NB = 8, S = 8192, D = 1024, FF = 2816, PW = 3072, M = NB * S, DEPTH = 4;
constexpr int NWAVES = 8, NTHR = 512;
#define LAS __attribute__((address_space(3)))
typedef unsigned short bf16;
typedef float f32x4 __attribute__((ext_vector_type(4)));
typedef float f32x2 __attribute__((ext_vector_type(2)));
typedef unsigned u32x4 __attribute__((ext_vector_type(4)));
typedef unsigned u32x2 __attribute__((ext_vector_type(2)));

__device__ __forceinline__ int ltid() { int t = threadIdx.x; asm volatile("" : "+v"(t)); return t; }
namespace at {
typedef short bf16x8 __attribute__((ext_vector_type(8)));
typedef short s16x4 __attribute__((ext_vector_type(4)));
typedef float f32x16 __attribute__((ext_vector_type(16)));
constexpr int KROW = 144, KBUF = 64 * KROW, VBUF = 16384, ATT_LDS = 2 * KBUF + 2 * VBUF;
constexpr float NEGF = -1e30f;
__device__ __forceinline__ unsigned cvtpk(float lo, float hi) { typedef __bf16 b2 __attribute__((ext_vector_type(2))); f32x2 v = {lo, hi}; b2 b = __builtin_convertvector(v, b2); return __builtin_bit_cast(unsigned, b); }
__device__ __forceinline__ float max3f(float a, float b, float c) { float r; asm("v_max3_f32 %0, %1, %2, %3" : "=v"(r) : "v"(a), "v"(b), "v"(c)); return r; }
__device__ __forceinline__ float partner_max(float v) { auto rr = __builtin_amdgcn_permlane32_swap(__float_as_uint(v), __float_as_uint(v), false, false); return fmaxf(__uint_as_float(rr[0]), __uint_as_float(rr[1])); }
__device__ __forceinline__ float partner_sum(float v) { auto rr = __builtin_amdgcn_permlane32_swap(__float_as_uint(v), __float_as_uint(v), false, false); return __uint_as_float(rr[0]) + __uint_as_float(rr[1]); }
__device__ __forceinline__ s16x4 vtr(const LAS unsigned char* p) { typedef short v4i16_t __attribute__((ext_vector_type(4))); return __builtin_bit_cast(s16x4, __builtin_amdgcn_ds_read_tr16_b64_v4i16((LAS v4i16_t*)p)); }
__device__ __forceinline__ bf16x8 pack8(const f32x16& p, int b) {
    u32x4 w; w.x = cvtpk(p[b], p[b + 1]); w.y = cvtpk(p[b + 2], p[b + 3]); w.z = cvtpk(p[b + 4], p[b + 5]); w.w = cvtpk(p[b + 6], p[b + 7]); return __builtin_bit_cast(bf16x8, w);
}

template <int DV>
__device__ __forceinline__ void sweep(LAS unsigned char* lds, const bf16* Kb, const bf16* Vb, size_t rstride, int t_lo, int t_hi, int W, int ql, int wq_lo,
                                      const bf16x8 (&qf)[4], f32x16 (&o)[DV / 32], float& m, float& l) {
    constexpr int NV = DV / 64, ND = DV / 32;
    const int tid = ltid(), lane = tid & 63, r32 = lane & 31, hi = lane >> 5;
    const int krow = tid >> 3, kch = tid & 7;
    const bf16* kg = Kb + (size_t)krow * rstride + kch * 8;
    const int kwoff = krow * KROW + kch * 16;
    const int vrow0 = (DV == 64) ? ((tid >> 4) * 2 + ((tid >> 2) & 1)) : ((tid >> 5) * 2 + ((tid >> 2) & 1));
    const int vch = (DV == 64) ? (((tid >> 3) & 1) * 4 + (tid & 3)) : (((tid >> 3) & 3) * 4 + (tid & 3));
    const bf16* vg = Vb + (size_t)vrow0 * rstride + vch * 8;
    int vwoff[NV];
#pragma unroll
    for (int i = 0; i < NV; ++i) { const int vr = vrow0 + 32 * i; vwoff[i] = (vch >> 2) * 4096 + (vr >> 4) * 1024 + (vr & 15) * 64 + (vch & 3) * 16; }
    const size_t tstep = (size_t)64 * rstride;
    u32x4 kregA, vregA[NV], kregB, vregB[NV];
#define AT_LOAD(KR_, VR_, T_) do { KR_ = *(const u32x4*)(kg + (size_t)(T_) * tstep); \
        _Pragma("unroll") for (int i = 0; i < NV; ++i) VR_[i] = *(const u32x4*)(vg + (size_t)(T_) * tstep + (size_t)(32 * i) * rstride); } while (0)
#define AT_WRITE(KR_, VR_) do { *(LAS u32x4*)(kbuf + kwoff) = KR_; \
        _Pragma("unroll") for (int i = 0; i < NV; ++i) *(LAS u32x4*)(vbuf + vwoff[i]) = VR_[i]; } while (0)
    AT_LOAD(kregA, vregA, t_lo);
    if (t_lo + 1 < t_hi) AT_LOAD(kregB, vregB, t_lo + 1);
    const int kroff = r32 * KROW + hi * 16;
    const int vroff = (4 * hi + ((lane & 15) >> 2)) * 64 + ((lane >> 4) & 1) * 32 + (lane & 3) * 8;
    f32x16 negm;
#pragma unroll
    for (int r = 0; r < 16; ++r) negm[r] = -m;
#define AT_TILE() do { \
        const int k0 = t * 64; \
        const bool relevant = (k0 <= wq_lo + 31) && (wq_lo - (k0 + 63) <= W); \
        if (relevant) { \
            bf16x8 kf[8]; \
_Pragma("unroll") \
            for (int d0 = 0; d0 < 4; ++d0) { kf[2 * d0] = *(const LAS bf16x8*)(kbuf + kroff + d0 * 32); kf[2 * d0 + 1] = *(const LAS bf16x8*)(kbuf + kroff + 32 * KROW + d0 * 32); } \
            f32x16 p0, p1; \
            p0 = __builtin_amdgcn_mfma_f32_32x32x16_bf16(kf[0], qf[0], negm, 0, 0, 0); \
            p1 = __builtin_amdgcn_mfma_f32_32x32x16_bf16(kf[1], qf[0], negm, 0, 0, 0); \
_Pragma("unroll") \
            for (int d0 = 1; d0 < 4; ++d0) { \
                p0 = __builtin_amdgcn_mfma_f32_32x32x16_bf16(kf[2 * d0], qf[d0], p0, 0, 0, 0); \
                p1 = __builtin_amdgcn_mfma_f32_32x32x16_bf16(kf[2 * d0 + 1], qf[d0], p1, 0, 0, 0); \
            } \
 \
            s16x4 vlo[2][4], vhh[2][4]; \
_Pragma("unroll") \
            for (int ks = 0; ks < 4; ++ks) { vlo[0][ks] = vtr(vbuf + vroff + ks * 1024); vhh[0][ks] = vtr(vbuf + vroff + ks * 1024 + 512); } \
            __builtin_amdgcn_sched_barrier(0); \
            const bool full = (k0 + 63 <= wq_lo) && (wq_lo + 31 - k0 <= W); \
            if (!full) { \
_Pragma("unroll") \
                for (int r = 0; r < 16; ++r) { \
                    const int kv = k0 + (r & 3) + 8 * (r >> 2) + 4 * hi; \
                    const bool v0 = (kv <= ql) && (ql - kv <= W), v1 = (kv + 32 <= ql) && (ql - kv - 32 <= W); \
                    p0[r] = v0 ? p0[r] : NEGF; p1[r] = v1 ? p1[r] : NEGF; \
                } \
            } \
            asm volatile("s_nop 15\n\ts_nop 7" : "+v"(p0), "+v"(p1)); \
            float rm; \
            { float a = max3f(p0[0], p0[1], p1[0]), b = max3f(p0[2], p0[3], p1[1]); a = max3f(a, p1[2], p1[3]); \
_Pragma("unroll") \
              for (int r = 4; r < 16; r += 4) { a = max3f(a, p0[r], p0[r + 1]); b = max3f(b, p0[r + 2], p0[r + 3]); a = max3f(a, p1[r], p1[r + 1]); b = max3f(b, p1[r + 2], p1[r + 3]); } \
              rm = fmaxf(a, b); } \
            rm = partner_max(rm); \
            if (__builtin_expect(__any(rm > 8.0f), 0)) { \
                const float dl = fmaxf(rm, 0.f); \
                m += dl; \
_Pragma("unroll") \
                for (int r = 0; r < 16; ++r) { p0[r] -= dl; p1[r] -= dl; negm[r] = -m; } \
                const float f = __builtin_amdgcn_exp2f(-dl); \
                l *= f; \
_Pragma("unroll") \
                for (int d = 0; d < ND; ++d) o[d] = o[d] * f; \
            } \
            float s0 = 0.f, s1 = 0.f; \
_Pragma("unroll") \
            for (int r = 0; r < 16; ++r) { p0[r] = __builtin_amdgcn_exp2f(p0[r]); p1[r] = __builtin_amdgcn_exp2f(p1[r]); s0 += p0[r]; asm volatile("" : "+v"(s0)); s1 += p1[r]; asm volatile("" : "+v"(s1)); } \
            l += s0 + s1; \
            bf16x8 pa[4]; \
            pa[0] = pack8(p0, 0); pa[1] = pack8(p0, 8); pa[2] = pack8(p1, 0); pa[3] = pack8(p1, 8); \
_Pragma("unroll") \
            for (int d = 0; d < ND; ++d) { \
                if (d + 1 < ND) { \
_Pragma("unroll") \
                    for (int ks = 0; ks < 4; ++ks) { vlo[(d + 1) & 1][ks] = vtr(vbuf + vroff + (d + 1) * 4096 + ks * 1024); vhh[(d + 1) & 1][ks] = vtr(vbuf + vroff + (d + 1) * 4096 + ks * 1024 + 512); } \
                } \
_Pragma("unroll") \
                for (int ks = 0; ks < 4; ++ks) { \
                    const s16x4 lo = vlo[d & 1][ks], hh = vhh[d & 1][ks]; \
                    const bf16x8 vf = (bf16x8){lo[0], lo[1], lo[2], lo[3], hh[0], hh[1], hh[2], hh[3]}; \
                    o[d] = __builtin_amdgcn_mfma_f32_32x32x16_bf16(vf, pa[ks], o[d], 0, 0, 0); \
                } \
                if (d + 1 < ND) __builtin_amdgcn_sched_barrier(0); \
            } \
        } \
    } while (0)

    for (int tt = t_lo, st = 0; tt < t_hi; tt += 2, ++st) {
        LAS unsigned char* kb0 = lds + (st & 1) * 2 * KBUF;
        LAS unsigned char* vb0 = lds + 4 * KBUF + (st & 1) * 2 * VBUF;
        { LAS unsigned char* kbuf = kb0; LAS unsigned char* vbuf = vb0; AT_WRITE(kregA, vregA); }
        { LAS unsigned char* kbuf = kb0 + KBUF; LAS unsigned char* vbuf = vb0 + VBUF; AT_WRITE(kregB, vregB); }
        __syncthreads();
        if (tt + 2 < t_hi) { AT_LOAD(kregA, vregA, tt + 2); AT_LOAD(kregB, vregB, tt + 3); }
        { LAS unsigned char* kbuf = kb0; LAS unsigned char* vbuf = vb0; const int t = tt; AT_TILE(); }
        { LAS unsigned char* kbuf = kb0 + KBUF; LAS unsigned char* vbuf = vb0 + VBUF; const int t = tt + 1; AT_TILE(); }
    }
#undef AT_LOAD
#undef AT_WRITE
    __syncthreads();
}

__device__ __forceinline__ void diff_unit(LAS unsigned char* lds, const bf16* proj, bf16* merged, float* stash, float lam, int b, int h, int qb, int blk) {
    const int tid = ltid(), lane = tid & 63, r32 = lane & 31, hi = lane >> 5;
    const int wid = __builtin_amdgcn_readfirstlane(tid >> 6);
    const size_t rowbase = (size_t)b * S;
    const int wq_lo = qb * 256 + wid * 32, ql = wq_lo + r32;
    const bf16* qrow = proj + (rowbase + ql) * PW + h * 128;
    const bf16* kb = proj + rowbase * PW + 512 + h * 128;
    const bf16* vb = proj + rowbase * PW + 1024 + h * 128;
    float* st = stash + ((size_t)blk * NTHR + tid) * 64;
    f32x16 o[4]; float inv = 0.f;
#pragma unroll 1
    for (int comp = 0; comp < 2; ++comp) {
        bf16x8 qf[4];
#pragma unroll
        for (int d0 = 0; d0 < 4; ++d0) qf[d0] = *(const bf16x8*)(qrow + comp * 64 + 16 * d0 + 8 * hi);
#pragma unroll
        for (int d = 0; d < 4; ++d) o[d] = (f32x16){};
        float m = 0.f, l = 0.f;
        sweep<128>(lds, kb + comp * 64, vb, (size_t)PW, 0, 4 * qb + 4, 1 << 30, ql, wq_lo, qf, o, m, l);
        l = partner_sum(l);
        inv = 1.0f / l;
        if (comp == 0) {
#pragma unroll
            for (int d = 0; d < 4; ++d)
#pragma unroll
                for (int r4 = 0; r4 < 4; ++r4)
                    *(f32x4*)(st + d * 16 + r4 * 4) = (f32x4){o[d][4 * r4] * inv, o[d][4 * r4 + 1] * inv, o[d][4 * r4 + 2] * inv, o[d][4 * r4 + 3] * inv};
        }
    }
    float ss = 0.f;
    const float li = lam * inv;
#pragma unroll
    for (int d = 0; d < 4; ++d)
#pragma unroll
        for (int r4 = 0; r4 < 4; ++r4) {
            const f32x4 s1 = *(const f32x4*)(st + d * 16 + r4 * 4);
#pragma unroll
            for (int i = 0; i < 4; ++i) { const float v = s1[i] - li * o[d][4 * r4 + i]; o[d][4 * r4 + i] = v; ss += v * v; }
        }
    ss = partner_sum(ss);
    const float rs = __builtin_amdgcn_rsqf(ss * (1.0f / 128.0f) + 1e-5f);
    bf16* orow = merged + (rowbase + ql) * D + h * 128 + 4 * hi;
#pragma unroll
    for (int d = 0; d < 4; ++d)
#pragma unroll
        for (int r4 = 0; r4 < 4; ++r4) {
            u32x2 w; w.x = cvtpk(o[d][4 * r4] * rs, o[d][4 * r4 + 1] * rs); w.y = cvtpk(o[d][4 * r4 + 2] * rs, o[d][4 * r4 + 3] * rs);
            *(u32x2*)(orow + 32 * d + 8 * r4) = w;
        }
}

__device__ __forceinline__ void dil_unit(LAS unsigned char* lds, const bf16* proj, bf16* part, f32x2* ml, int b, int head, int dil, int res, int lblk) {
    const int tid = ltid(), lane = tid & 63, r32 = lane & 31, hi = lane >> 5;
    const int wid = __builtin_amdgcn_readfirstlane(tid >> 6);
    const int wq_lo = lblk * 256 + wid * 32, ql = wq_lo + r32;
    const size_t row = (size_t)b * S + (size_t)ql * dil + res;
    const bf16* qrow = proj + row * PW + 1536 + head * 64;
    const bf16* kb = proj + ((size_t)b * S + res) * PW + 2048 + head * 64;
    const bf16* vb = proj + ((size_t)b * S + res) * PW + 2560 + head * 64;
    bf16x8 qf[4];
#pragma unroll
    for (int d0 = 0; d0 < 4; ++d0) qf[d0] = *(const bf16x8*)(qrow + 16 * d0 + 8 * hi);
    f32x16 o[2]; o[0] = (f32x16){}; o[1] = (f32x16){};
    float m = 0.f, l = 0.f;
    const int t_lo = (4 * lblk - 2) > 0 ? (4 * lblk - 2) : 0;
    sweep<64>(lds, kb, vb, (size_t)dil * PW, t_lo, 4 * lblk + 4, 128, ql, wq_lo, qf, o, m, l);
    l = partner_sum(l);
    const float inv = 1.0f / l;
    bf16* orow = part + row * 512 + head * 64 + 4 * hi;
#pragma unroll
    for (int d = 0; d < 2; ++d)
#pragma unroll
        for (int r4 = 0; r4 < 4; ++r4) {
            u32x2 w; w.x = cvtpk(o[d][4 * r4] * inv, o[d][4 * r4 + 1] * inv); w.y = cvtpk(o[d][4 * r4 + 2] * inv, o[d][4 * r4 + 3] * inv);
            *(u32x2*)(orow + 32 * d + 8 * r4) = w;
        }
    if (hi == 0) ml[row * 8 + head] = (f32x2){m, l};
}

__device__ __forceinline__ void dil_stream(LAS unsigned char* lds, const bf16* proj, bf16* part_base, f32x2* ml_base, int u0, int ustep, int utotal) {
    constexpr int ND = 2, W = 128, VB = 8192, VOFF = 6 * KBUF;
    const int tid = ltid(), lane = tid & 63, r32 = lane & 31, hi = lane >> 5;
    const int wid = __builtin_amdgcn_readfirstlane(tid >> 6);
    const int krow = tid >> 3, kch = tid & 7;
    const int kwoff = krow * KROW + kch * 16;
    const int vrow0 = (tid >> 4) * 2 + ((tid >> 2) & 1), vch = ((tid >> 3) & 1) * 4 + (tid & 3);
    const int vwoff = (vch >> 2) * 4096 + (vrow0 >> 4) * 1024 + (vrow0 & 15) * 64 + (vch & 3) * 16;
    const int kroff = r32 * KROW + hi * 16;
    const int vroff = (4 * hi + ((lane & 15) >> 2)) * 64 + ((lane >> 4) & 1) * 32 + (lane & 3) * 8;
    u32x4 kst[6], vst[6]; bf16x8 qn[4];
    int u = u0; if (u >= utotal) return;
    int cb, chead, cdil, cres, clblk, cbr;
#define DS_DECODE(U_) do { cbr = (U_) >> 11; const int rem_ = (U_) & 2047, bhd_ = rem_ >> 5, blk_ = rem_ & 31; const int sh_ = (cbr == 0) ? 5 : (cbr == 1 ? 3 : 1); \
        cdil = (cbr == 0) ? 1 : (cbr == 1 ? 4 : 16); cb = bhd_ >> 3; chead = bhd_ & 7; cres = blk_ >> sh_; clblk = blk_ & ((1 << sh_) - 1); } while (0)
#define DS_LOAD() do { const int tl_ = (4 * clblk - 2) > 0 ? (4 * clblk - 2) : 0, nt_ = 4 * clblk + 4 - tl_; \
        const bf16* base_ = proj + ((size_t)cb * S + cres) * PW + chead * 64; const size_t rs_ = (size_t)cdil * PW; \
        _Pragma("unroll") for (int j = 0; j < 6; ++j) if (j < nt_) { \
            kst[j] = *(const u32x4*)(base_ + 2048 + (size_t)((tl_ + j) * 64 + krow) * rs_ + kch * 8); \
            vst[j] = *(const u32x4*)(base_ + 2560 + (size_t)((tl_ + j) * 64 + vrow0) * rs_ + vch * 8); } \
        const bf16* q_ = proj + ((size_t)cb * S + (size_t)(clblk * 256 + wid * 32 + r32) * cdil + cres) * PW + 1536 + chead * 64 + 8 * hi; \
        _Pragma("unroll") for (int d0 = 0; d0 < 4; ++d0) qn[d0] = *(const bf16x8*)(q_ + 16 * d0); } while (0)
    DS_DECODE(u);
    DS_LOAD();
    for (;;) {
        const int t_lo = (4 * clblk - 2) > 0 ? (4 * clblk - 2) : 0, ntu = 4 * clblk + 4 - t_lo;
#pragma unroll
        for (int j = 0; j < 6; ++j) if (j < ntu) { *(LAS u32x4*)(lds + j * KBUF + kwoff) = kst[j]; *(LAS u32x4*)(lds + VOFF + j * VB + vwoff) = vst[j]; }
        bf16x8 qf[4];
#pragma unroll
        for (int d0 = 0; d0 < 4; ++d0) qf[d0] = qn[d0];
        __syncthreads();
        const int wq_lo = clblk * 256 + wid * 32, ql = wq_lo + r32;
        const size_t row = (size_t)cb * S + (size_t)ql * cdil + cres;
        const int head = chead;
        bf16* part = part_base + (size_t)cbr * M * 512; f32x2* ml = ml_base + (size_t)cbr * M * 8;
        const int un = u + ustep; const bool has_next = un < utotal;
        if (has_next) { DS_DECODE(un); DS_LOAD(); }
        f32x16 o[2]; o[0] = (f32x16){}; o[1] = (f32x16){};
        float m = 0.f, l = 0.f;
        f32x16 negm = (f32x16){};
#pragma unroll
        for (int j = 0; j < 6; ++j) if (j < ntu) {
            LAS unsigned char* kbuf = lds + j * KBUF;
            LAS unsigned char* vbuf = lds + VOFF + j * VB;
            const int t = t_lo + j;
            AT_TILE();
        }
        l = partner_sum(l);
        const float inv = 1.0f / l;
        bf16* orow = part + row * 512 + head * 64 + 4 * hi;
#pragma unroll
        for (int d = 0; d < 2; ++d)
#pragma unroll
            for (int r4 = 0; r4 < 4; ++r4) {
                u32x2 w; w.x = cvtpk(o[d][4 * r4] * inv, o[d][4 * r4 + 1] * inv); w.y = cvtpk(o[d][4 * r4 + 2] * inv, o[d][4 * r4 + 3] * inv);
                *(u32x2*)(orow + 32 * d + 8 * r4) = w;
            }
        if (hi == 0) ml[row * 8 + head] = (f32x2){m, l};
        __syncthreads();
        if (!has_next) break;
        u = un;
    }
#undef DS_DECODE
#undef DS_LOAD
}
#undef AT_TILE
}

constexpr size_t MiB = (size_t)1 << 20;
constexpr size_t WS_ROPE = 1 * MiB;
constexpr size_t WS_SSP = 3 * MiB;
constexpr size_t WS_W = 8 * MiB;
constexpr size_t W_GU1 = 0, W_D1 = 11 * MiB, W_GU2 = W_D1 + 5 * MiB + 512 * 1024, W_D2 = W_GU2 + 11 * MiB, W_IN = W_D2 + 5 * MiB + 512 * 1024, W_OUT = W_IN + 6 * MiB;
constexpr size_t WS_XB = 64 * MiB;
constexpr size_t WS_PROJ = 192 * MiB;
constexpr size_t WS_MRG = 576 * MiB;
constexpr size_t WS_PART = 704 * MiB;
constexpr size_t WS_ML = 896 * MiB;
constexpr size_t WS_STASH = 908 * MiB;
constexpr size_t WS_W1 = 940 * MiB;
constexpr size_t WS_END = 984 * MiB;
constexpr int LDS_BYTES = 147456;

#define XB_TMO      128
#define XB_XCNT(j)  (256  + 64 * (j))
#define XB_XSUB(j)  (1280 + 64 * (j))
#define XB_XGEN(j)  (2304 + 64 * (j))
#define XB_TOP      3328
#define XB_TOPGEN   3392
#define XCD_BAR_WORDS 3456
#define XB_SPIN_CAP (1u << 18)

__device__ __forceinline__ unsigned xb_ld(unsigned* p)              { return __hip_atomic_load(p, __ATOMIC_RELAXED, __HIP_MEMORY_SCOPE_AGENT); }
__device__ __forceinline__ unsigned xb_add(unsigned* p, unsigned v) { return __hip_atomic_fetch_add(p, v, __ATOMIC_RELAXED, __HIP_MEMORY_SCOPE_AGENT); }
__device__ __forceinline__ unsigned xb_xcc_id() { return (unsigned)__builtin_amdgcn_s_getreg((3 << 11) | 20) & 0xFu; }
#define XB_SPIN(cond, bar) do { unsigned _sp = 0; while (cond) { __builtin_amdgcn_s_sleep(1); \
    if ((++_sp & 255u) == 0u) { if (xb_ld(&(bar)[XB_TMO])) break; if (_sp > XB_SPIN_CAP) { atomicAdd(&(bar)[XB_TMO], 1u); break; } } } } while (0)

struct XcdBarrier {
    unsigned* bar; unsigned x;
    volatile LAS unsigned* st;
};

__device__ __forceinline__ XcdBarrier xcd_barrier_post(unsigned* bar, volatile LAS unsigned* st) {
    XcdBarrier b; b.bar = bar; b.x = xb_xcc_id(); b.st = st;
    if (threadIdx.x == 0) (void)xb_add(&bar[XB_XCNT(b.x)], 1u);
    return b;
}
__device__ __forceinline__ void xcd_barrier_complete(unsigned* bar, unsigned x, unsigned& nloc, unsigned& nx) {
    const unsigned G = gridDim.x * gridDim.y * gridDim.z;
    unsigned sum, cnt, mine, sp = 0u;
    for (;;) {
        sum = 0u; cnt = 0u; mine = 0u;
#pragma unroll
        for (unsigned j = 0; j < 16; ++j) { const unsigned c = xb_ld(&bar[XB_XCNT(j)]); sum += c; cnt += (c > 0u) ? 1u : 0u; mine = (j == x) ? c : mine; }
        if (sum == G) break;
        __builtin_amdgcn_s_sleep(1);
        if ((++sp & 255u) == 0u) { if (xb_ld(&bar[XB_TMO])) break; if (sp > XB_SPIN_CAP) { atomicAdd(&bar[XB_TMO], 1u); break; } }
    }
    nloc = mine > 0u ? mine : 1u; nx = cnt > 0u ? cnt : 1u;
}

__device__ __forceinline__ void xcd_barrier(const XcdBarrier& b) {
    asm volatile("s_waitcnt vmcnt(0)" ::: "memory");
    __syncthreads();
    if (threadIdx.x == 0) {
        unsigned* bar = b.bar;
        __builtin_amdgcn_s_waitcnt(0);
        unsigned nloc = b.st[0], nx = b.st[1];
        if (nloc == 0u) { xcd_barrier_complete(bar, b.x, nloc, nx); b.st[0] = nloc; b.st[1] = nx; }
        const unsigned old = xb_add(&bar[XB_XSUB(b.x)], 1u);
        const unsigned gen = old / nloc;
        if (old + 1u == (gen + 1u) * nloc) {
            __builtin_amdgcn_fence(__ATOMIC_RELEASE, "agent");
            asm volatile("s_waitcnt vmcnt(0)" ::: "memory");
            const unsigned og = xb_add(&bar[XB_TOP], 1u);
            const unsigned tg = og / nx;
            if (og + 1u == (tg + 1u) * nx) xb_add(&bar[XB_TOPGEN], 1u);
            else XB_SPIN(xb_ld(&bar[XB_TOPGEN]) == tg, bar);
            __builtin_amdgcn_fence(__ATOMIC_ACQUIRE, "agent");
            xb_add(&bar[XB_XGEN(b.x)], 1u);
            asm volatile("s_waitcnt vmcnt(0)" ::: "memory");
        } else {
            XB_SPIN(xb_ld(&bar[XB_XGEN(b.x)]) == gen, bar);
            __builtin_amdgcn_fence(__ATOMIC_ACQUIRE, "agent");
            asm volatile("s_waitcnt vmcnt(0)" ::: "memory");
        }
    }
    __syncthreads();
}

constexpr size_t WS_BAR = 0, BAR_ZERO_BYTES = 16384;
constexpr int LDS_MISC = 131072 + 512;
struct Args { const void* in[20]; float* out; unsigned char* ws; float lam_init[4]; int ph_lo, ph_hi; };

__device__ __forceinline__ float wave_sum(float v) {
#pragma unroll
    for (int o = 1; o < 64; o <<= 1) v += __shfl_xor(v, o);
    return v;
}
__device__ __forceinline__ unsigned f2bf(float f) { unsigned u = __builtin_bit_cast(unsigned, f); return (u + 0x7fffu + ((u >> 16) & 1u)) >> 16; }
__device__ __forceinline__ unsigned pk2(float lo, float hi) { return f2bf(lo) | (f2bf(hi) << 16); }
__device__ __forceinline__ float bf2f(unsigned short h) { return __builtin_bit_cast(float, (unsigned)h << 16); }

__device__ __forceinline__ void conv_item(const float* W, int K, int N, bf16* WT, int rmode, int part, int gmode, const float* g0, const float* g1, float gs, LAS float* scr, int item, int lane) {
    const int nblk = N / 32, kb = item / nblk, nb = item % nblk, k0 = 64 * kb, n0 = 32 * nb;
#pragma unroll 8
    for (int i = 0; i < 32; ++i) {
        const int kk = 2 * i + (lane >> 5), k = k0 + kk;
        float g = 1.0f;
        if (gmode == 1) g = g0[k]; else if (gmode == 2) g = (k < 512) ? g0[k & 127] * gs : g1[k - 512];
        scr[kk * 33 + (lane & 31)] = W[(size_t)k * N + n0 + (lane & 31)] * g;
    }
    asm volatile("s_waitcnt lgkmcnt(0)" ::: "memory");
    const int c = lane & 7;
#pragma unroll
    for (int j = 0; j < 4; ++j) {
        const int nl = (lane >> 3) + 8 * j, n = n0 + nl; const LAS float* s = scr + (8 * c) * 33 + nl;
        int rowd = n;
        if (rmode == 1) rowd = ((n >> 7) << 8) + part * 128 + (n & 127);
        else if (rmode == 2) { const int cc = n & 255; rowd = (n & ~255) + ((cc >> 5) & 1) * 128 + (cc >> 6) * 32 + (cc & 31); }
        u32x4 o; o.x = pk2(s[0 * 33], s[1 * 33]); o.y = pk2(s[2 * 33], s[3 * 33]); o.z = pk2(s[4 * 33], s[5 * 33]); o.w = pk2(s[6 * 33], s[7 * 33]);
        *(u32x4*)(WT + (size_t)rowd * K + k0 + 8 * c) = o;
    }
    asm volatile("s_waitcnt lgkmcnt(0)" ::: "memory");
}

typedef const Args __attribute__((address_space(4)))* ArgsP;
__device__ __forceinline__ void convert_layer(ArgsP ap, int l, LAS unsigned char* lds, int gw, int ngw, int wave, int lane) {
    LAS float* scr = (LAS float*)(lds + wave * 16384);
    unsigned char* wb = ap->ws + ((l & 1) ? WS_W1 : WS_W);
    constexpr int I_G = (D / 64) * (FF / 32), I_D = (FF / 64) * (D / 32), I_IN = (D / 64) * (PW / 32), I_OUT = (D / 64) * (D / 32);
    constexpr int NITEMS = 4 * I_G + 2 * I_D + I_IN + I_OUT;
    const size_t wgu = (size_t)D * FF;
    const float* n1 = (const float*)ap->in[2] + l * D; const float* n2 = (const float*)ap->in[15] + l * D; const float* nm = (const float*)ap->in[6] + l * D;
    for (int it = gw; it < NITEMS; it += ngw) {
        int r = it;
        if (r < I_G) { conv_item((const float*)ap->in[3] + l * wgu, D, FF, (bf16*)(wb + W_GU1), 1, 0, 1, n1, nullptr, 1.f, scr, r, lane); continue; } r -= I_G;
        if (r < I_G) { conv_item((const float*)ap->in[4] + l * wgu, D, FF, (bf16*)(wb + W_GU1), 1, 1, 1, n1, nullptr, 1.f, scr, r, lane); continue; } r -= I_G;
        if (r < I_D) { conv_item((const float*)ap->in[5] + l * wgu, FF, D, (bf16*)(wb + W_D1), 0, 0, 0, nullptr, nullptr, 1.f, scr, r, lane); continue; } r -= I_D;
        if (r < I_G) { conv_item((const float*)ap->in[16] + l * wgu, D, FF, (bf16*)(wb + W_GU2), 1, 0, 1, n2, nullptr, 1.f, scr, r, lane); continue; } r -= I_G;
        if (r < I_G) { conv_item((const float*)ap->in[17] + l * wgu, D, FF, (bf16*)(wb + W_GU2), 1, 1, 1, n2, nullptr, 1.f, scr, r, lane); continue; } r -= I_G;
        if (r < I_D) { conv_item((const float*)ap->in[18] + l * wgu, FF, D, (bf16*)(wb + W_D2), 0, 0, 0, nullptr, nullptr, 1.f, scr, r, lane); continue; } r -= I_D;
        if (r < I_IN) { conv_item((const float*)ap->in[7] + (size_t)l * D * PW, D, PW, (bf16*)(wb + W_IN), 2, 0, 1, nm, nullptr, 1.f, scr, r, lane); continue; } r -= I_IN;
        conv_item((const float*)ap->in[14] + (size_t)l * D * D, D, D, (bf16*)(wb + W_OUT), 0, 0, 2, (const float*)ap->in[12] + l * 128, (const float*)ap->in[13] + l * 512, 1.0f - ap->lam_init[l], scr, r, lane);
    }
}

__global__ void __launch_bounds__(NTHR, 2) mega(Args a) {
    extern __shared__ __attribute__((aligned(16))) unsigned char lds_raw[];
    LAS unsigned char* lds = (LAS unsigned char*)lds_raw;
    const int ph_lo = a.ph_lo, ph_hi = a.ph_hi;
    volatile LAS unsigned* bst = (volatile LAS unsigned*)(lds + LDS_MISC);
    if (threadIdx.x < 2) bst[threadIdx.x] = 0u;
    __syncthreads();
    XcdBarrier bar; bar.bar = (unsigned*)(a.ws + WS_BAR); bar.x = 0; bar.st = bst;
    if (ph_hi - ph_lo > 1) bar = xcd_barrier_post((unsigned*)(a.ws + WS_BAR), bst);
    for (int ph = ph_lo; ph < ph_hi; ++ph) {
        const int tid = ltid(), lane = tid & 63, wave = __builtin_amdgcn_readfirstlane(tid >> 6);
        int G = gridDim.x, bx = blockIdx.x; asm volatile("" : "+s"(G), "+s"(bx));
        const int vcu = (G % 8 == 0) ? (bx % 8) * (G / 8) + bx / 8 : bx;
        const int gw = vcu * NWAVES + wave, ngw = G * NWAVES;
        ArgsP ap = (ArgsP)__builtin_amdgcn_kernarg_segment_ptr();
        asm volatile("" : "+s"(ap));
        unsigned char* ws = ap->ws;
        float* X = ap->out;
        bf16* XB = (bf16*)(ws + WS_XB);
        float* ssp = (float*)(ws + WS_SSP);
        float* cs = (float*)(ws + WS_ROPE);
        bf16* PROJ = (bf16*)(ws + WS_PROJ);
        bf16* HB = (bf16*)(ws + WS_PROJ);
        bf16* MRG = (bf16*)(ws + WS_MRG);
        if (ph == 0) {
            const float* xin = (const float*)ap->in[0];
            for (int row = gw; row < M; row += ngw) {
                const f32x4* xr = (const f32x4*)(xin + (size_t)row * D) + lane;
                u32x2* xb = (u32x2*)(XB + (size_t)row * D) + lane;
                float s = 0.f;
#pragma unroll
                for (int j = 0; j < 4; ++j) {
                    const f32x4 v = xr[64 * j]; s += (v[0] * v[0] + v[1] * v[1]) + (v[2] * v[2] + v[3] * v[3]);
                    u32x2 w; w.x = pk2(v[0], v[1]); w.y = pk2(v[2], v[3]); xb[64 * j] = w;
                }
                s = wave_sum(s);
                if (lane < 16) ssp[(size_t)row * 16 + lane] = (lane == 0) ? s : 0.f;
            }
            const int* pos = (const int*)ap->in[1];
            for (int idx = bx * NTHR + tid; idx < S * 32; idx += G * NTHR) {
                const int s_ = idx >> 5, j = idx & 31;
                double inv = 1.0; for (int q = 0; q < j; ++q) inv *= 0.7498942093324559;
                const float invf = (float)inv;
                const float angf = (float)pos[s_] * invf;
                const double ang = (double)angf;
                const double kk = __builtin_rint(ang * 0.15915494309189535);
                const double r = ang - kk * 6.283185307179586;
                const double x2 = r * r;
                double c = 1.0, sn = r, tc = 1.0, ts = r;
#pragma unroll
                for (int k = 1; k <= 14; ++k) { tc *= -x2 / (double)((2 * k - 1) * (2 * k)); c += tc; ts *= -x2 / (double)((2 * k) * (2 * k + 1)); sn += ts; }
                cs[(size_t)s_ * 64 + j] = (float)c; cs[(size_t)s_ * 64 + 32 + j] = (float)sn;
            }
            convert_layer(ap, 0, lds, gw, ngw, wave, lane);
        } else if (ph == 1 + 8 * DEPTH) {
            const float* g = (const float*)ap->in[19];
            for (int row = gw; row < M; row += ngw) {
                const u32x2* xb = (const u32x2*)(XB + (size_t)row * D) + lane;
                f32x4* xo = (f32x4*)(X + (size_t)row * D) + lane;
                f32x4 v[4]; float s = 0.f;
#pragma unroll
                for (int j = 0; j < 4; ++j) { const u32x2 w = xb[64 * j];
                    v[j] = (f32x4){__builtin_bit_cast(float, w.x << 16), __builtin_bit_cast(float, w.x & 0xffff0000u), __builtin_bit_cast(float, w.y << 16), __builtin_bit_cast(float, w.y & 0xffff0000u)};
                    s += (v[j][0] * v[j][0] + v[j][1] * v[j][1]) + (v[j][2] * v[j][2] + v[j][3] * v[j][3]); }
                const float rs = 1.0f / sqrtf(wave_sum(s) * (1.0f / D) + 1e-6f);
#pragma unroll
                for (int j = 0; j < 4; ++j) { const f32x4 gg = ((const f32x4*)g)[lane + 64 * j]; xo[64 * j] = v[j] * rs * gg; }
            }
        } else {
            const int l = (ph - 1) / 8, k = (ph - 1) % 8;
            unsigned char* wb = ws + ((l & 1) ? WS_W1 : WS_W);
            if (k == 0 || k == 6) {
                pg8::Gemm g{XB, (const bf16*)(wb + (k == 0 ? W_GU1 : W_GU2)), M, 2 * FF, D};
                pg8::StaticOrder SO; SO.init(M, 2 * FF, G, bx);
                pg8::EpiGU E{HB, ssp, FF};
#ifndef SK_GU
                for (int rep_ = 0; rep_ < REP_GU; ++rep_)
                pg8::gemm_phase<pg8::EpiGU, pg8::StaticOrder, true, true>(lds, g, SO, E);
#endif
            } else if (k == 1 || k == 7 || k == 5) {
                pg8::Gemm g{k == 5 ? MRG : HB, (const bf16*)(wb + (k == 1 ? W_D1 : (k == 7 ? W_D2 : W_OUT))), M, D, k == 5 ? D : FF};
                pg8::StaticOrder SO; SO.init(M, D, G, bx);
#ifndef SK_RES
                for (int rep_ = 0; rep_ < REP_RES; ++rep_) {
                pg8::EpiRes E{XB, ssp, rep_ + 1 < REP_RES ? 0.0f : (k == 5 ? 1.0f : 0.5f)};
                pg8::gemm_phase<pg8::EpiRes, pg8::StaticOrder, true, true>(lds, g, SO, E);
                }
#endif
            } else if (k == 2) {
                pg8::Gemm g{XB, (const bf16*)(wb + W_IN), M, PW, D};
                pg8::StaticOrder SO; SO.init(M, PW, G, bx);
                pg8::EpiProj E{PROJ, ssp, cs};
#ifndef SK_PROJ
                for (int rep_ = 0; rep_ < REP_PROJ; ++rep_)
                pg8::gemm_phase<pg8::EpiProj, pg8::StaticOrder, true, true>(lds, g, SO, E);
#endif
            } else if (k == 3) {
                float s1 = ((const float*)ap->in[8])[l * 64 + lane] * ((const float*)ap->in[9])[l * 64 + lane];
                float s2 = ((const float*)ap->in[10])[l * 64 + lane] * ((const float*)ap->in[11])[l * 64 + lane];
                s1 = wave_sum(s1); s2 = wave_sum(s2);
                const float lam = expf(s1) - expf(s2) + ap->lam_init[l];
                float* stash = (float*)(ws + WS_STASH);
              for (int rep_ = 0; rep_ < REP_DIFF; ++rep_)
                for (int r = 0; r < 4; ++r) {
                    const int per = G >> 3, xcd = vcu / per, i = vcu % per;
                    const int bh = (xcd * 4 + r) & 31, qb = ((r & 1) ? 31 - i : i) & 31;
#ifndef SK_DIFF
                    if (per == 32 && (G & 7) == 0) at::diff_unit(lds, PROJ, MRG, stash, lam, bh >> 2, bh & 3, qb, bx);
#endif
                }
              if ((G >> 3) != 32 || (G & 7))
                for (int pi = vcu; pi < 512; pi += G)
#pragma unroll 1
                    for (int i = 0; i < 2; ++i) { const int bh = pi >> 4, s_ = pi & 15, qb = i ? 31 - s_ : s_; at::diff_unit(lds, PROJ, MRG, stash, lam, bh >> 2, bh & 3, qb, bx); }
              for (int rep_ = 0; rep_ < REP_DIL; ++rep_)
                at::dil_stream(lds, PROJ, (bf16*)(ws + WS_PART), (f32x2*)(ws + WS_ML), vcu, G, 6144);
                for (int rep_ = 0; rep_ < REP_MISC; ++rep_)
                if (l + 1 < DEPTH) convert_layer(ap, l + 1, lds, gw, ngw, wave, lane);
            } else if (k == 4) {
                const bf16* part = (const bf16*)(ws + WS_PART); const f32x2* ml = (const f32x2*)(ws + WS_ML);
                for (int rep_ = 0; rep_ < REP_MISC; ++rep_)
                for (int row = gw; row < M; row += ngw) {
                    u32x4 pv[3]; f32x2 mv[3];
#pragma unroll
                    for (int b = 0; b < 3; ++b) { pv[b] = *(const u32x4*)(part + ((size_t)b * M + row) * 512 + 8 * lane); mv[b] = ml[((size_t)b * M + row) * 8 + (lane >> 3)]; }
                    const float mall = fmaxf(mv[0].x, fmaxf(mv[1].x, mv[2].x));
                    float w[3], wsum = 0.f;
#pragma unroll
                    for (int b = 0; b < 3; ++b) { w[b] = mv[b].y * __builtin_amdgcn_exp2f(mv[b].x - mall); wsum += w[b]; }
                    const float iw = 1.0f / wsum;
                    float o[8]; float ss = 0.f;
#pragma unroll
                    for (int i = 0; i < 8; ++i) {
                        float acc = 0.f;
#pragma unroll
                        for (int b = 0; b < 3; ++b) { const unsigned wd = pv[b][i >> 1]; acc += w[b] * bf2f((unsigned short)((i & 1) ? (wd >> 16) : (wd & 0xffffu))); }
                        o[i] = acc * iw; ss += o[i] * o[i];
                    }
                    const float rs = __builtin_amdgcn_rsqf(wave_sum(ss) * (1.0f / 512.0f) + 1e-6f);
                    u32x4 wv; wv.x = pk2(o[0] * rs, o[1] * rs); wv.y = pk2(o[2] * rs, o[3] * rs); wv.z = pk2(o[4] * rs, o[5] * rs); wv.w = pk2(o[6] * rs, o[7] * rs);
                    *(u32x4*)(MRG + (size_t)row * D + 512 + 8 * lane) = wv;
                }
            }
        }
        if (ph + 1 < ph_hi) {
            for (int rep_ = 0; rep_ < REP_SYNC; ++rep_) { if (ph == ph_lo) cg::this_grid().sync(); else xcd_barrier(bar); }
        }
    }
}

extern "C" void kernel_launch(void* const* d_in, const int* in_sizes, int n_in, void* d_out, int out_size, void* d_ws, size_t ws_size, hipStream_t stream) {
    static int grid = 0;
    if (grid == 0) {
        if (n_in != 20 || out_size != M * D || ws_size < WS_END) { fprintf(stderr, "kernel_launch: unexpected problem (n_in %d, out %d, ws %zu)\n", n_in, out_size, ws_size); grid = -1; return; }
        int dev = 0, cus = 0, per_cu = 0;
        hipGetDevice(&dev);
        hipDeviceGetAttribute(&cus, hipDeviceAttributeMultiprocessorCount, dev);
        if (hipFuncSetAttribute((const void*)mega, hipFuncAttributeMaxDynamicSharedMemorySize, LDS_BYTES) != hipSuccess) { fprintf(stderr, "kernel_launch: hipFuncSetAttribute failed\n"); grid = -1; return; }
        if (hipOccupancyMaxActiveBlocksPerMultiprocessor(&per_cu, (const void*)mega, NTHR, LDS_BYTES) != hipSuccess || per_cu < 1) { fprintf(stderr, "kernel_launch: occupancy query says %d\n", per_cu); per_cu = 1; (void)hipGetLastError(); }
        grid = cus * per_cu;
    }
    if (grid < 0) return;
    Args a{};
    for (int i = 0; i < 20; ++i) a.in[i] = d_in[i];
    a.out = (float*)d_out; a.ws = (unsigned char*)d_ws;
    a.lam_init[0] = 0.2f; a.lam_init[1] = (float)(0.8 - 0.6 * 0.7408182206817179); a.lam_init[2] = (float)(0.8 - 0.6 * 0.5488116360940264); a.lam_init[3] = (float)(0.8 - 0.6 * 0.4065696597405991);
    constexpr int NPH = 2 + 8 * DEPTH;
#if MK_PER_PHASE
    for (int ph = 0; ph < NPH; ++ph) {
        a.ph_lo = ph; a.ph_hi = ph + 1;
        hipLaunchKernelGGL(mega, dim3(grid), dim3(NTHR), LDS_BYTES, stream, a);
    }
#else
    a.ph_lo = 0; a.ph_hi = NPH;
    if (hipMemsetAsync((char*)d_ws + WS_BAR, 0, BAR_ZERO_BYTES, stream) != hipSuccess) { fprintf(stderr, "kernel_launch: hipMemsetAsync failed\n"); return; }
    void* args[] = {&a};
    hipError_t e = hipLaunchCooperativeKernel((const void*)mega, dim3(grid), dim3(NTHR), args, LDS_BYTES, stream);
    if (e != hipSuccess) fprintf(stderr, "kernel_launch: cooperative launch failed: %s (grid %d)\n", hipGetErrorString(e), grid);
#endif
}
```
